# Optimizing an MI355X kernel written in HIP

```python
import math
import jax, jax.numpy as jnp
from jax import lax
import numpy as np

D_MODEL = 1024
BATCH = 8
SEQ = 2048
DEPTH = 4

RMS_EPS = 1e-6
D_FF = 2816

SSD_WIDTH = D_MODEL
SSD_HEADDIM = 64
SSD_HEADS = SSD_WIDTH // SSD_HEADDIM
SSD_GROUPS = 2
SSD_HPG = SSD_HEADS // SSD_GROUPS
SSD_STATE = 128
SSD_CONV = 5
SSD_CHUNK = 128
SSD_XBC = SSD_WIDTH + 2 * SSD_GROUPS * SSD_STATE

MLA_HEADS = 8
MLA_Q_LORA = D_MODEL // 4
MLA_KV_LORA = D_MODEL // 8
MLA_NOPE = 64
MLA_ROPE = 32
MLA_QK = MLA_NOPE + MLA_ROPE
MLA_V = 64
MLA_WIDTH = MLA_HEADS * MLA_V
ROPE_BASE = 10000.0
ATTN_BLOCK = 128

CONV_WIDTH = D_MODEL // 2
CONV_GROUPS = 8
CONV_K = 3

D_MIX = SSD_WIDTH + MLA_WIDTH + CONV_WIDTH
IN_SIZES = (SSD_WIDTH, SSD_XBC, 2 * SSD_HEADS, MLA_Q_LORA, MLA_KV_LORA, MLA_ROPE, CONV_WIDTH, CONV_WIDTH, CONV_WIDTH)
D_IN = SSD_WIDTH + SSD_XBC + 2 * SSD_HEADS + MLA_Q_LORA + MLA_KV_LORA + MLA_ROPE + 3 * CONV_WIDTH

kernel_name = 'hybrid_ssd_mla_conv_macaron_encoder'


def rms_norm(x, g):
    xf = x.astype(jnp.float32)
    y = xf * lax.rsqrt(jnp.mean(xf * xf, axis=-1, keepdims=True) + RMS_EPS)
    return (y * g.astype(jnp.float32)).astype(x.dtype)


def group_rms_norm(x, g, n_groups):
    shp = x.shape
    xg = x.reshape(shp[:-1] + (n_groups, shp[-1] // n_groups))
    return rms_norm(xg, g.reshape(n_groups, -1)).reshape(shp)


def swiglu(x, w_gate, w_up, w_down):
    return (jax.nn.silu(x @ w_gate) * (x @ w_up)) @ w_down


def depthwise_conv(x, w):
    k, c = w.shape
    return lax.conv_general_dilated(x, w[:, None, :].astype(x.dtype), window_strides=(1,),
                                    padding=[(k // 2, k // 2)],
                                    dimension_numbers=('NWC', 'WIO', 'NWC'),
                                    feature_group_count=c)


def rope(x, pos):
    half = x.shape[-1] // 2
    inv = ROPE_BASE ** (-jnp.arange(half, dtype=jnp.float32) / half)
    ang = pos.astype(jnp.float32)[..., None] * inv
    cos = jnp.cos(ang)[:, :, None, :]
    sin = jnp.sin(ang)[:, :, None, :]
    xf = x.astype(jnp.float32)
    x1, x2 = xf[..., :half], xf[..., half:]
    return jnp.concatenate([x1 * cos - x2 * sin, x1 * sin + x2 * cos], axis=-1).astype(x.dtype)


def split_points(sizes):
    pts, acc = [], 0
    for n in sizes[:-1]:
        acc += n
        pts.append(acc)
    return pts


def ssd_chunked(x, dt, a, bm, cm):
    bsz, s = x.shape[0], x.shape[1]
    nc, L = s // SSD_CHUNK, SSD_CHUNK
    xc = x.reshape(bsz, nc, L, SSD_GROUPS, SSD_HPG, SSD_HEADDIM)
    dtc = dt.reshape(bsz, nc, L, SSD_GROUPS, SSD_HPG)
    bc = bm.reshape(bsz, nc, L, SSD_GROUPS, SSD_STATE)
    cc = cm.reshape(bsz, nc, L, SSD_GROUPS, SSD_STATE)
    xd = xc * dtc[..., None]
    a_cs = jnp.cumsum(dtc * a, axis=2)
    seg = a_cs[:, :, :, None] - a_cs[:, :, None, :]
    lower = jnp.tril(jnp.ones((L, L), dtype=bool))[None, None, :, :, None, None]
    decay = jnp.exp(jnp.where(lower, seg, -jnp.inf))
    cb = jnp.einsum('bclgn,bcsgn->bclsg', cc, bc)
    y_diag = jnp.einsum('bclsg,bclsgr,bcsgrp->bclgrp', cb, decay, xd)
    decay_states = jnp.exp(a_cs[:, :, -1:] - a_cs)
    states = jnp.einsum('bclgn,bclgr,bclgrp->bcgrpn', bc, decay_states, xd)
    chunk_decay = jnp.exp(a_cs[:, :, -1])

    def step(carry, inp):
        st, dec = inp
        return carry * dec[..., None, None] + st, carry

    init = jnp.zeros_like(states[:, 0])
    _, prev = lax.scan(step, init, (jnp.moveaxis(states, 1, 0), jnp.moveaxis(chunk_decay, 1, 0)))
    prev = jnp.moveaxis(prev, 0, 1)
    y_off = jnp.einsum('bclgn,bcgrpn,bclgr->bclgrp', cc, prev, jnp.exp(a_cs))
    return (y_diag + y_off).reshape(bsz, s, SSD_GROUPS, SSD_HPG, SSD_HEADDIM)


def ssd_mixer(z, xbc, dt_raw, conv_w, conv_b, dt_bias, a_log, d_skip, norm_g):
    bsz, s = z.shape[0], z.shape[1]
    xbc = jax.nn.silu(depthwise_conv(xbc, conv_w) + conv_b)
    xs = xbc[..., :SSD_WIDTH].reshape(bsz, s, SSD_GROUPS, SSD_HPG, SSD_HEADDIM).astype(jnp.float32)
    bm = xbc[..., SSD_WIDTH:SSD_WIDTH + SSD_GROUPS * SSD_STATE].reshape(bsz, s, SSD_GROUPS, SSD_STATE).astype(jnp.float32)
    cm = xbc[..., SSD_WIDTH + SSD_GROUPS * SSD_STATE:].reshape(bsz, s, SSD_GROUPS, SSD_STATE).astype(jnp.float32)
    dt = jax.nn.softplus(dt_raw.astype(jnp.float32).reshape(bsz, s, 2, SSD_GROUPS, SSD_HPG)
                         + dt_bias.astype(jnp.float32).reshape(2, SSD_GROUPS, SSD_HPG))
    a = -jnp.exp(a_log.astype(jnp.float32)).reshape(2, SSD_GROUPS, SSD_HPG)
    y_fwd = ssd_chunked(xs, dt[:, :, 0], a[0], bm, cm)
    y_bwd = jnp.flip(ssd_chunked(jnp.flip(xs, 1), jnp.flip(dt[:, :, 1], 1), a[1],
                                 jnp.flip(bm, 1), jnp.flip(cm, 1)), 1)
    y = y_fwd + y_bwd + xs * d_skip.astype(jnp.float32).reshape(SSD_GROUPS, SSD_HPG)[..., None]
    y = y.reshape(bsz, s, SSD_WIDTH) * jax.nn.silu(z.astype(jnp.float32))
    return group_rms_norm(y, norm_g, SSD_GROUPS).astype(z.dtype)


def mla_mixer(q_lat, kv_lat, k_pe, positions, q_norm, w_uq, kv_norm, w_ukv,
              q_head_norm, k_head_norm, out_norm):
    bsz, s = q_lat.shape[0], q_lat.shape[1]
    q = (rms_norm(q_lat, q_norm) @ w_uq).reshape(bsz, s, MLA_HEADS, MLA_QK)
    kv = (rms_norm(kv_lat, kv_norm) @ w_ukv).reshape(bsz, s, MLA_HEADS, MLA_NOPE + MLA_V)
    k_nope, v = kv[..., :MLA_NOPE], kv[..., MLA_NOPE:]
    k = jnp.concatenate([k_nope, jnp.broadcast_to(k_pe[:, :, None, :], (bsz, s, MLA_HEADS, MLA_ROPE))], axis=-1)
    q = rms_norm(q, q_head_norm)
    k = rms_norm(k, k_head_norm)
    q = jnp.concatenate([q[..., :MLA_NOPE], rope(q[..., MLA_NOPE:], positions)], axis=-1)
    k = jnp.concatenate([k[..., :MLA_NOPE], rope(k[..., MLA_NOPE:], positions)], axis=-1)
    scale = MLA_QK ** -0.5
    nb = s // ATTN_BLOCK
    q_blocks = q.reshape(bsz, nb, ATTN_BLOCK, MLA_HEADS, MLA_QK).swapaxes(0, 1)

    def attend(qb):
        sc = jnp.einsum('bqhd,bkhd->bhqk', qb, k).astype(jnp.float32) * scale
        p = jax.nn.softmax(sc, axis=-1).astype(v.dtype)
        return jnp.einsum('bhqk,bkhd->bqhd', p, v)

    o = lax.map(attend, q_blocks).swapaxes(0, 1).reshape(bsz, s, MLA_HEADS, MLA_V)
    return rms_norm(o, out_norm.reshape(MLA_HEADS, MLA_V)).reshape(bsz, s, MLA_WIDTH)


def conv_mixer(h_in, b_gate, c_gate, conv_w, out_norm):
    y = b_gate * depthwise_conv(c_gate * h_in, conv_w)
    return group_rms_norm(y, out_norm, CONV_GROUPS)


def setup_inputs(seed: int = 0) -> dict:
    key = jax.random.key(seed)
    k = jax.random.split(key, 32)
    f32 = jnp.float32

    def w(i, shape, fan_in):
        return jax.random.normal(k[i], shape, f32) * (fan_in ** -0.5)

    def gain(i, shape):
        return 1.0 + 0.05 * jax.random.normal(k[i], shape, f32)

    u = jax.random.uniform(k[9], (DEPTH, 2, SSD_HEADS), f32)
    dt0 = jnp.exp(u * (math.log(0.1) - math.log(1e-3)) + math.log(1e-3))
    ssd_dt_bias = dt0 + jnp.log(-jnp.expm1(-dt0))
    ssd_a_log = jnp.log(jax.random.uniform(k[10], (DEPTH, 2, SSD_HEADS), f32, 1.0, 16.0))
    positions = jnp.broadcast_to(jnp.arange(SEQ, dtype=jnp.int32)[None, :], (BATCH, SEQ))
    return {
        'x': jax.random.normal(k[0], (BATCH, SEQ, D_MODEL), f32),
        'positions': positions,
        'ffn1_norm': gain(1, (DEPTH, D_MODEL)),
        'ffn1_w_gate': w(2, (DEPTH, D_MODEL, D_FF), D_MODEL),
        'ffn1_w_up': w(3, (DEPTH, D_MODEL, D_FF), D_MODEL),
        'ffn1_w_down': w(4, (DEPTH, D_FF, D_MODEL), D_FF),
        'mix_norm': gain(5, (DEPTH, D_MODEL)),
        'w_in': w(6, (DEPTH, D_MODEL, D_IN), D_MODEL),
        'ssd_conv_w': w(7, (DEPTH, SSD_CONV, SSD_XBC), SSD_CONV),
        'ssd_conv_b': 0.02 * jax.random.normal(k[8], (DEPTH, SSD_XBC), f32),
        'ssd_dt_bias': ssd_dt_bias,
        'ssd_a_log': ssd_a_log,
        'ssd_d': 1.0 + 0.1 * jax.random.normal(k[11], (DEPTH, SSD_HEADS), f32),
        'ssd_norm': gain(12, (DEPTH, SSD_WIDTH)),
        'mla_q_norm': gain(13, (DEPTH, MLA_Q_LORA)),
        'mla_w_uq': w(14, (DEPTH, MLA_Q_LORA, MLA_HEADS * MLA_QK), MLA_Q_LORA),
        'mla_kv_norm': gain(15, (DEPTH, MLA_KV_LORA)),
        'mla_w_ukv': w(16, (DEPTH, MLA_KV_LORA, MLA_HEADS * (MLA_NOPE + MLA_V)), MLA_KV_LORA),
        'mla_q_head_norm': gain(17, (DEPTH, MLA_QK)),
        'mla_k_head_norm': gain(18, (DEPTH, MLA_QK)),
        'mla_out_norm': gain(19, (DEPTH, MLA_WIDTH)),
        'conv_w': w(20, (DEPTH, CONV_K, CONV_WIDTH), CONV_K),
        'conv_out_norm': gain(21, (DEPTH, CONV_WIDTH)),
        'w_out': w(22, (DEPTH, D_MIX, D_MODEL), D_MIX),
        'ffn2_norm': gain(23, (DEPTH, D_MODEL)),
        'ffn2_w_gate': w(24, (DEPTH, D_MODEL, D_FF), D_MODEL),
        'ffn2_w_up': w(25, (DEPTH, D_MODEL, D_FF), D_MODEL),
        'ffn2_w_down': w(26, (DEPTH, D_FF, D_MODEL), D_FF),
    }


def reference(x, positions, ffn1_norm, ffn1_w_gate, ffn1_w_up, ffn1_w_down, mix_norm, w_in,
              ssd_conv_w, ssd_conv_b, ssd_dt_bias, ssd_a_log, ssd_d, ssd_norm,
              mla_q_norm, mla_w_uq, mla_kv_norm, mla_w_ukv, mla_q_head_norm, mla_k_head_norm,
              mla_out_norm, conv_w, conv_out_norm, w_out,
              ffn2_norm, ffn2_w_gate, ffn2_w_up, ffn2_w_down):
    pts = split_points(IN_SIZES)
    for l in range(DEPTH):
        x = x + 0.5 * swiglu(rms_norm(x, ffn1_norm[l]), ffn1_w_gate[l], ffn1_w_up[l], ffn1_w_down[l])
        h = rms_norm(x, mix_norm[l])
        u = h @ w_in[l]
        z, xbc, dt_raw, q_lat, kv_lat, k_pe, c_h, c_b, c_c = jnp.split(u, pts, axis=-1)
        y_ssd = ssd_mixer(z, xbc, dt_raw, ssd_conv_w[l], ssd_conv_b[l], ssd_dt_bias[l],
                          ssd_a_log[l], ssd_d[l], ssd_norm[l])
        y_mla = mla_mixer(q_lat, kv_lat, k_pe, positions, mla_q_norm[l], mla_w_uq[l], mla_kv_norm[l],
                          mla_w_ukv[l], mla_q_head_norm[l], mla_k_head_norm[l], mla_out_norm[l])
        y_conv = conv_mixer(c_h, c_b, c_c, conv_w[l], conv_out_norm[l])
        x = x + jnp.concatenate([y_ssd, y_mla, y_conv], axis=-1) @ w_out[l]
        x = x + 0.5 * swiglu(rms_norm(x, ffn2_norm[l]), ffn2_w_gate[l], ffn2_w_up[l], ffn2_w_down[l])
    return x
```

```cpp
#include <hip/hip_runtime.h>
#include <hip/hip_cooperative_groups.h>
#include <cstdio>
#include <cstdint>
namespace cg = cooperative_groups;
__device__ __forceinline__ int ltid() { int t = threadIdx.x; asm volatile("" : "+v"(t)); return t; }
__device__ __forceinline__ int lbid() { int t = blockIdx.x; asm volatile("" : "+s"(t)); return t; }

#ifndef USE_XCD_BAR
#define USE_XCD_BAR 1
#endif
#ifndef REP_SSD
#define REP_SSD 1
#endif
#ifndef REP_ATT
#define REP_ATT 1
#endif
#ifndef REP_GU
#define REP_GU 1
#endif
#ifndef REP_IN
#define REP_IN 1
#endif
#ifndef REP_CV
#define REP_CV 1
#endif
#ifndef REP_P4R
#define REP_P4R 1
#endif
#ifndef REP_CMB
#define REP_CMB 1
#endif
#ifndef MK_MULTI
#define MK_MULTI 0
#endif

namespace pg8 {
#define PG8_LAS __attribute__((address_space(3)))
typedef unsigned short bf16_t;
typedef short bf16x8 __attribute__((ext_vector_type(8)));
typedef float f32x4 __attribute__((ext_vector_type(4)));
typedef unsigned u32x4 __attribute__((ext_vector_type(4)));
constexpr int BM = 256, BK = 64, HALF = 128, HTB = HALF * BK * 2, STAGE_BYTES = 8 * HTB, NXCD = 8, WGM = 8;

__host__ __device__ __forceinline__ int lds_byte(int r, int c) { const int st = (r >> 4) * 2 + (c >> 5), rr = r & 15, cc = c & 31, ob = rr * 64 + cc * 2; return st * 1024 + (ob ^ (((ob >> 9) & 1) << 5)); }
__host__ __device__ __forceinline__ void stage_rc(int b, int& R, int& C) { const int st = b / 1024, sb = b % 1024, swz = sb ^ (((sb >> 9) & 1) << 5); R = (st >> 1) * 16 + swz / 64; C = (st & 1) * 32 + (swz % 64) / 2; }
__host__ __device__ __forceinline__ int perm32(int rho) { const int n = rho >> 4, i = rho & 15; return 8 * (i >> 2) + 4 * n + (i & 3); }

struct Unit { int pm, pn; };
struct Gemm { const bf16_t* A; const bf16_t* Bt; int M, N, K, lda, ldb; };

struct StaticOrder {
    int nM, nN, nwg, G, c;
    __host__ __device__ void init(int M, int N, int G_, int c_) { nM = M / BM; nN = N / BM; nwg = nM * nN; G = G_; c = c_; }
    __host__ __device__ bool next(int i, Unit& u) const {
        const long L = (long)i * G + c; if (L >= nwg) return false;
        int wgid = (int)L; { const int q = nwg / NXCD, r = nwg % NXCD, xcd = wgid % NXCD, off = wgid / NXCD; wgid = (xcd < r ? xcd * (q + 1) : r * (q + 1) + (xcd - r) * q) + off; }
        const int nig = WGM * nN, gid = wgid / nig, fm = gid * WGM, gsz = (nM - fm) < WGM ? (nM - fm) : WGM;
        u.pm = fm + ((wgid % nig) % gsz); u.pn = (wgid % nig) / gsz; return true;
    }
};

typedef float f32x2_t __attribute__((ext_vector_type(2))); typedef __bf16 bf16x2_t __attribute__((ext_vector_type(2)));
__device__ __forceinline__ unsigned cvt_pk_bf16(float lo, float hi) { f32x2_t v = {lo, hi}; bf16x2_t b = __builtin_convertvector(v, bf16x2_t); return __builtin_bit_cast(unsigned, b); }

template <class Epi, class Sched, bool ALIGN_EPI>
__device__ __forceinline__ void gemm_phase(PG8_LAS unsigned char* lds, const Gemm g, const Sched& S, const Epi& E) {
    const int tid = ltid(), wid = __builtin_amdgcn_readfirstlane(tid >> 6), lane = tid & 63, wr = wid >> 2, wc = wid & 3, fr = lane & 15, fq = lane >> 4;
    int K = g.K; asm volatile("" : "+s"(K)); const int nt = K / BK;
    unsigned voffA[2], voffB[2];
#pragma unroll
    for (int i = 0; i < 2; ++i) { int R, C; stage_rc(tid * 16 + i * 8192, R, C); const int Rb = (R & ~31) + perm32(R & 31);
        voffA[i] = (unsigned)(R * g.lda + C) * 2u; voffB[i] = (unsigned)(Rb * g.ldb + C) * 2u; }
    const size_t kstep = (size_t)(BK * 2);
    const size_t hstepA = (size_t)HALF * g.lda * 2, hstepB = (size_t)HALF * g.ldb * 2;
    const size_t tstepA = 2 * hstepA, tstepB = 2 * hstepB;
    const unsigned ldsw = (unsigned)wid * 1024u;
    const int aoff = lds_byte(wr * 64 + fr, fq * 8), boff = lds_byte(wc * 32 + fr, fq * 8);
#define PG8_SA(b, h) (((b) * 2 + (h)) * HTB)
#define PG8_SB(b, h) ((4 + (b) * 2 + (h)) * HTB)
#define PG8_STAGE(bufoff, gbase, voff) do { _Pragma("unroll") for (int _i = 0; _i < 2; ++_i) \
        __builtin_amdgcn_global_load_lds((const unsigned*)((const char*)(gbase) + (voff)[_i]), (PG8_LAS unsigned*)(lds + (bufoff) + ldsw + _i * 8192), 16, 0, 0); } while (0)
#define PG8_LDA(dst, b, h) do { _Pragma("unroll") for (int m = 0; m < 4; ++m) _Pragma("unroll") for (int k = 0; k < 2; ++k) dst[m][k] = *(const PG8_LAS bf16x8*)(lds + PG8_SA(b, h) + aoff + m * 2048 + k * 1024); } while (0)
#define PG8_LDB(dst, b, h) do { _Pragma("unroll") for (int n = 0; n < 2; ++n) _Pragma("unroll") for (int k = 0; k < 2; ++k) dst[n][k] = *(const PG8_LAS bf16x8*)(lds + PG8_SB(b, h) + boff + n * 2048 + k * 1024); } while (0)
#define PG8_MMA(ai, bj, At, Bt) do { __builtin_amdgcn_s_setprio(1); _Pragma("unroll") for (int m = 0; m < 4; ++m) _Pragma("unroll") for (int n = 0; n < 2; ++n) _Pragma("unroll") for (int k = 0; k < 2; ++k) \
        acc[ai][bj][m][n] = __builtin_amdgcn_mfma_f32_16x16x32_bf16(Bt[n][k], At[m][k], acc[ai][bj][m][n], 0, 0, 0); __builtin_amdgcn_s_setprio(0); } while (0)
#define PG8_WAIT_V(n) asm volatile("s_waitcnt vmcnt(" #n ")" ::: "memory")
#define PG8_WAIT_L(n) asm volatile("s_waitcnt lgkmcnt(" #n ")" ::: "memory")
#define PG8_BAR __builtin_amdgcn_s_barrier()
#define PG8_SCHED __builtin_amdgcn_sched_barrier(0)
    Unit cur, nxt; int ui = 0;
    if (!S.next(0, cur)) return;
    f32x4 acc[2][2][4][2];
#pragma unroll
    for (int a = 0; a < 2; ++a)
#pragma unroll
        for (int b = 0; b < 2; ++b)
#pragma unroll
            for (int m = 0; m < 4; ++m)
#pragma unroll
                for (int n = 0; n < 2; ++n) acc[a][b][m][n] = (f32x4){0.f, 0.f, 0.f, 0.f};
    bf16x8 At[4][2], B0[2][2], B1[2][2];
    const char* cA = (const char*)g.A + (size_t)cur.pm * tstepA; const char* cB = (const char*)g.Bt + (size_t)cur.pn * tstepB;
    PG8_STAGE(PG8_SB(0, 0), cB, voffB); PG8_STAGE(PG8_SB(0, 1), cB + hstepB, voffB); PG8_STAGE(PG8_SA(0, 0), cA, voffA); PG8_STAGE(PG8_SA(0, 1), cA + hstepA, voffA);
    if (wr == 1) PG8_BAR;
    PG8_WAIT_V(2); PG8_BAR;
    PG8_STAGE(PG8_SB(1, 0), cB + kstep, voffB); PG8_STAGE(PG8_SA(1, 0), cA + kstep, voffA); PG8_STAGE(PG8_SB(1, 1), cB + hstepB + kstep, voffB);
    PG8_WAIT_V(6); PG8_BAR;
    for (;;) {
        const bool has_next = S.next(ui + 1, nxt);
        const char* nA = has_next ? (const char*)g.A + (size_t)nxt.pm * tstepA : cA; const char* nB = has_next ? (const char*)g.Bt + (size_t)nxt.pn * tstepB : cB;
#pragma unroll 1
        for (int t = 0; t < nt; t += 2) {
            const bool last = (t == nt - 2);
            const char* a1 = cA + (size_t)(t + 1) * kstep;
            const char* a2 = last ? nA : cA + (size_t)(t + 2) * kstep; const char* b2 = last ? nB : cB + (size_t)(t + 2) * kstep;
            const char* a3 = a2 + kstep; const char* b3 = b2 + kstep;
            PG8_LDB(B0, 0, 0); PG8_LDB(B1, 0, 1); PG8_SCHED; PG8_LDA(At, 0, 0); PG8_STAGE(PG8_SA(1, 1), a1 + hstepA, voffA);
            PG8_WAIT_V(8); PG8_WAIT_L(0); PG8_BAR; PG8_MMA(0, 0, At, B0); PG8_MMA(0, 1, At, B1); PG8_BAR; PG8_SCHED;
            PG8_LDA(At, 0, 1); PG8_STAGE(PG8_SB(0, 0), b2, voffB); PG8_STAGE(PG8_SB(0, 1), b2 + hstepB, voffB); PG8_STAGE(PG8_SA(0, 0), a2, voffA);
            PG8_WAIT_V(8); PG8_WAIT_L(0); PG8_BAR; PG8_MMA(1, 0, At, B0); PG8_MMA(1, 1, At, B1); PG8_BAR; PG8_SCHED;
            PG8_LDB(B0, 1, 0); PG8_LDB(B1, 1, 1); PG8_SCHED; PG8_LDA(At, 1, 0); PG8_STAGE(PG8_SA(0, 1), a2 + hstepA, voffA);
            PG8_WAIT_V(8); PG8_WAIT_L(0); PG8_BAR; PG8_MMA(0, 0, At, B0); PG8_MMA(0, 1, At, B1); PG8_BAR; PG8_SCHED;
            PG8_LDA(At, 1, 1); PG8_STAGE(PG8_SB(1, 0), b3, voffB); PG8_STAGE(PG8_SB(1, 1), b3 + hstepB, voffB); PG8_STAGE(PG8_SA(1, 0), a3, voffA);
            PG8_WAIT_V(8); PG8_WAIT_L(0); PG8_BAR; PG8_MMA(1, 0, At, B0); PG8_MMA(1, 1, At, B1); PG8_BAR; PG8_SCHED;
        }
        if constexpr (ALIGN_EPI) { if (wr == 0) PG8_BAR; }
        E(acc, cur, wr, wc, fr, fq);
        if (!has_next) break;
#pragma unroll
        for (int a = 0; a < 2; ++a)
#pragma unroll
            for (int b = 0; b < 2; ++b)
#pragma unroll
                for (int m = 0; m < 4; ++m)
#pragma unroll
                    for (int n = 0; n < 2; ++n) acc[a][b][m][n] = (f32x4){0.f, 0.f, 0.f, 0.f};
        cur = nxt; cA = nA; cB = nB; ++ui;
        if constexpr (ALIGN_EPI) { if (wr == 1) PG8_BAR; }
    }
    PG8_WAIT_V(0);
    if constexpr (!ALIGN_EPI) { if (wr == 0) PG8_BAR; }
    PG8_BAR;
#undef PG8_SA
#undef PG8_SB
#undef PG8_STAGE
#undef PG8_LDA
#undef PG8_LDB
#undef PG8_MMA
#undef PG8_WAIT_V
#undef PG8_WAIT_L
#undef PG8_BAR
#undef PG8_SCHED
}
}


typedef unsigned long long u64_t;
__device__ __forceinline__ void wt16b(const void* base, void* p, pg8::u32x4 v) {
    const __amdgpu_buffer_rsrc_t r = __builtin_amdgcn_make_buffer_rsrc((void*)base, 0, 0x7fffffff, 0x00020000);
    __builtin_amdgcn_raw_buffer_store_b128(v, r, (unsigned)((const char*)p - (const char*)base), 0, 16);
}
#define wt16(p, v) wt16b(WSB, (p), (v))
#define wt16f(p, v) wt16b(WSB, (p), __builtin_bit_cast(pg8::u32x4, (v)))
#define wt16f_base(b, p, v) wt16b((b), (p), __builtin_bit_cast(pg8::u32x4, (v)))
__device__ __forceinline__ void wt8(void* p, unsigned lo, unsigned hi) { __hip_atomic_store((u64_t*)p, (u64_t)lo | ((u64_t)hi << 32), __ATOMIC_RELAXED, __HIP_MEMORY_SCOPE_AGENT); }
__device__ __forceinline__ void wt4f(float* p, float v) { __hip_atomic_store(p, v, __ATOMIC_RELAXED, __HIP_MEMORY_SCOPE_AGENT); }
using pg8::bf16_t; using pg8::f32x4; using pg8::u32x4; using pg8::bf16x8; using pg8::cvt_pk_bf16;
typedef float f32x16 __attribute__((ext_vector_type(16)));
typedef unsigned u32x2 __attribute__((ext_vector_type(2)));
#define LAS __attribute__((address_space(3)))

constexpr int NB = 8, SEQ = 2048, T = NB * SEQ, DM = 1024, FF = 2816, DEPTH = 4;
constexpr int XLD = 2048;
constexpr int HLD = 4096;
constexpr int NU = 4608;
constexpr int DIN = 4544;
constexpr int UZ = 0, UX = 1024, UB = 2048, UC = 2304, UQ = 2560, UKV = 2816, UPE = 2944, UDT = 2976, UCH = 3072, UCB = 3584, UCC = 4096;
constexpr float EPS = 1e-6f;
constexpr int NWAVES = 8, NTHR = 512;
constexpr int LDS_BYTES = 147456;

constexpr size_t MiB = 1u << 20;
constexpr size_t WS_CTL = 0;
constexpr size_t CTL_ROWSS = 0;
constexpr size_t CTL_QSS = (size_t)T * 16 * 4;
constexpr size_t CTL_KVSS = CTL_QSS + (size_t)T * 4 * 4;
constexpr size_t CTL_END = CTL_KVSS + (size_t)T * 4 * 4;
constexpr size_t WS_BAR = WS_CTL + 1536 * 1024;
static_assert(CTL_END <= WS_BAR, "ctl map");
constexpr size_t WS_CS = 2 * MiB;
constexpr size_t WS_DT = 4 * MiB;
constexpr size_t WS_W = 6 * MiB;
constexpr size_t W_GU1 = 0, W_D1 = W_GU1 + (size_t)5632 * 1024 * 2, W_IN = W_D1 + (size_t)1024 * HLD * 2, W_UQ = W_IN + (size_t)NU * 1024 * 2,
                 W_UKV = W_UQ + (size_t)768 * 256 * 2, W_OUT = W_UKV + (size_t)1024 * 128 * 2, W_GU2 = W_OUT + (size_t)1024 * 2048 * 2, W_D2 = W_GU2 + (size_t)5632 * 1024 * 2,
                 W_END = W_D2 + (size_t)1024 * HLD * 2;
constexpr size_t WS_U = WS_W + ((W_END + MiB - 1) / MiB) * MiB;
constexpr size_t WS_XB = WS_U + (size_t)T * NU * 2;
constexpr size_t WS_Y = WS_XB + (size_t)T * XLD * 2;
constexpr size_t WS_QR = WS_Y + (size_t)T * 2048 * 2;
constexpr size_t WS_KF = WS_QR + (size_t)T * 768 * 2;
constexpr size_t WS_VT = WS_KF + (size_t)T * 768 * 2;
constexpr size_t WS_YF = WS_VT + (size_t)T * 512 * 2;
constexpr size_t WS_END = WS_YF + (size_t)T * 1024 * 2;
static_assert(WS_END <= 457509120ull && (size_t)T * HLD * 2 <= (size_t)T * NU * 2, "workspace map must fit sum(inputs) bytes; H overlays U");

struct Args {
    const float* x; const int* pos;
    const float *ffn1_norm, *ffn1_wg, *ffn1_wu, *ffn1_wd, *mix_norm, *w_in, *ssd_conv_w, *ssd_conv_b, *ssd_dt_bias, *ssd_a_log, *ssd_d, *ssd_norm,
                *mla_q_norm, *mla_w_uq, *mla_kv_norm, *mla_w_ukv, *mla_qhn, *mla_khn, *mla_out_norm, *conv_w, *conv_out_norm, *w_out,
                *ffn2_norm, *ffn2_wg, *ffn2_wu, *ffn2_wd;
    float* out; unsigned char* ws;
    int ph_lo, ph_hi;
};

typedef const __attribute__((address_space(4))) Args* CArgs;
__device__ __forceinline__ CArgs get_args() { CArgs p = (CArgs)__builtin_amdgcn_kernarg_segment_ptr(); asm volatile("" : "+s"(p)); return p; }
__device__ __forceinline__ float bf2f(unsigned short h) { return __uint_as_float((unsigned)h << 16); }
__device__ __forceinline__ void unpack8(const u32x4 v, float (&f)[8]) {
#pragma unroll
    for (int i = 0; i < 4; ++i) { f[2 * i] = __uint_as_float(v[i] << 16); f[2 * i + 1] = __uint_as_float(v[i] & 0xffff0000u); }
}
__device__ __forceinline__ u32x4 pack8(const float (&f)[8]) { u32x4 v; v.x = cvt_pk_bf16(f[0], f[1]); v.y = cvt_pk_bf16(f[2], f[3]); v.z = cvt_pk_bf16(f[4], f[5]); v.w = cvt_pk_bf16(f[6], f[7]); return v; }
__device__ __forceinline__ unsigned short f2bf(float f) { return (unsigned short)(cvt_pk_bf16(f, 0.f) & 0xffffu); }
__device__ __forceinline__ float silu_f(float x) { return x * __builtin_amdgcn_rcpf(1.f + __expf(-x)); }
__device__ __forceinline__ float softplus_f(float x) { return fmaxf(x, 0.f) + log1pf(__expf(-fabsf(x))); }

__device__ __forceinline__ float sum16(const float* p) {
    const f32x4 a = *(const f32x4*)p, b = *(const f32x4*)(p + 4), c = *(const f32x4*)(p + 8), d = *(const f32x4*)(p + 12);
    return (((a[0] + a[1]) + (a[2] + a[3])) + ((b[0] + b[1]) + (b[2] + b[3]))) + (((c[0] + c[1]) + (c[2] + c[3])) + ((d[0] + d[1]) + (d[2] + d[3])));
}
__device__ __forceinline__ float sum4q(const f32x4 a) { return (a[0] + a[1]) + (a[2] + a[3]); }
__device__ __forceinline__ float sum4(const float* p) { const f32x4 a = *(const f32x4*)p; return (a[0] + a[1]) + (a[2] + a[3]); }
struct EpiSwiglu {
    const unsigned char* WSB;
    bf16_t* H; const float* rowss;
    __device__ __forceinline__ void operator()(const f32x4 (&acc)[2][2][4][2], const pg8::Unit& u, int wr, int wc, int fr, int fq) const {
        const int row0 = u.pm * 256 + wr * 64 + fr, col0 = u.pn * 128 + wc * 32 + 8 * fq;
        f32x4 rq[2][4];
#pragma unroll
        for (int ai = 0; ai < 2; ++ai)
#pragma unroll
            for (int m = 0; m < 4; ++m) rq[ai][m] = *(const f32x4*)(rowss + (size_t)(row0 + ai * 128 + m * 16) * 16 + 4 * fq);
#pragma unroll
        for (int ai = 0; ai < 2; ++ai)
#pragma unroll
            for (int m = 0; m < 4; ++m) {
                const int row = row0 + ai * 128 + m * 16;
                float ssq = sum4q(rq[ai][m]); ssq += __shfl_xor(ssq, 16); ssq += __shfl_xor(ssq, 32);
                const float r = rsqrtf(ssq * (1.f / DM) + EPS);
                float h[8];
#pragma unroll
                for (int n = 0; n < 2; ++n)
#pragma unroll
                    for (int i = 0; i < 4; ++i) h[4 * n + i] = silu_f(acc[ai][0][m][n][i] * r) * (acc[ai][1][m][n][i] * r);
                wt16(H + (size_t)row * HLD + col0, pack8(h));
            }
    }
};
struct EpiResid {
    const unsigned char* WSB;
    const float* base; float* out; bf16_t* xb; float* ss; float scale;
    __device__ __forceinline__ void operator()(const f32x4 (&acc)[2][2][4][2], const pg8::Unit& u, int wr, int wc, int fr, int fq) const {
        const int row0 = u.pm * 256 + wr * 64 + fr, col0 = u.pn * 256 + wc * 32 + 8 * fq;
        f32x4 pre[4][2][2];
#pragma unroll
        for (int m = 0; m < 4; ++m)
#pragma unroll
            for (int bj = 0; bj < 2; ++bj) { const size_t off = (size_t)(row0 + m * 16) * DM + col0 + bj * 128;
                pre[m][bj][0] = *(const f32x4*)(base + off); pre[m][bj][1] = *(const f32x4*)(base + off + 4); }
#pragma unroll
        for (int ai = 0; ai < 2; ++ai)
#pragma unroll
            for (int m = 0; m < 4; ++m) {
                const int row = row0 + ai * 128 + m * 16; float part = 0.f;
                f32x4 v[2][2];
#pragma unroll
                for (int bj = 0; bj < 2; ++bj) { v[bj][0] = pre[m][bj][0] + acc[ai][bj][m][0] * scale; v[bj][1] = pre[m][bj][1] + acc[ai][bj][m][1] * scale; }
                if (ai == 0) {
#pragma unroll
                    for (int bj = 0; bj < 2; ++bj) { const size_t off2 = (size_t)(row + 128) * DM + col0 + bj * 128;
                        pre[m][bj][0] = *(const f32x4*)(base + off2); pre[m][bj][1] = *(const f32x4*)(base + off2 + 4); }
                }
#pragma unroll
                for (int bj = 0; bj < 2; ++bj) {
                    const size_t off = (size_t)row * DM + col0 + bj * 128;
                    const f32x4 v0 = v[bj][0], v1 = v[bj][1];
                    *(f32x4*)(out + off) = v0; *(f32x4*)(out + off + 4) = v1;
                    u32x4 w; w.x = cvt_pk_bf16(v0[0], v0[1]); w.y = cvt_pk_bf16(v0[2], v0[3]); w.z = cvt_pk_bf16(v1[0], v1[1]); w.w = cvt_pk_bf16(v1[2], v1[3]);
                    wt16(xb + (size_t)row * XLD + col0 + bj * 128, w);
                    part += (v0[0] * v0[0] + v0[1] * v0[1]) + (v0[2] * v0[2] + v0[3] * v0[3]) + (v1[0] * v1[0] + v1[1] * v1[1]) + (v1[2] * v1[2] + v1[3] * v1[3]);
                }
                part += __shfl_xor(part, 16); part += __shfl_xor(part, 32);
                if (fq == 0) wt4f(ss + (size_t)row * 16 + u.pn * 4 + wc, part);
            }
    }
};
struct EpiU {
    const unsigned char* WSB;
    bf16_t* U; const float* rowss; float* qss; float* kvss; float* DT; const float* dt_bias;
    __device__ __forceinline__ void operator()(const f32x4 (&acc)[2][2][4][2], const pg8::Unit& u, int wr, int wc, int fr, int fq) const {
        const int row0 = u.pm * 256 + wr * 64 + fr, col0 = u.pn * 256 + wc * 32 + 8 * fq; const int pn = u.pn;
        f32x4 rq[2][4];
#pragma unroll
        for (int ai = 0; ai < 2; ++ai)
#pragma unroll
            for (int m = 0; m < 4; ++m) rq[ai][m] = *(const f32x4*)(rowss + (size_t)(row0 + ai * 128 + m * 16) * 16 + 4 * fq);
#pragma unroll
        for (int ai = 0; ai < 2; ++ai)
#pragma unroll
            for (int m = 0; m < 4; ++m) {
                const int row = row0 + ai * 128 + m * 16;
                float ssq = sum4q(rq[ai][m]); ssq += __shfl_xor(ssq, 16); ssq += __shfl_xor(ssq, 32);
                const float r = rsqrtf(ssq * (1.f / DM) + EPS);
                float sq = 0.f;
#pragma unroll
                for (int bj = 0; bj < 2; ++bj) {
                    float v[8];
#pragma unroll
                    for (int n = 0; n < 2; ++n)
#pragma unroll
                        for (int i = 0; i < 4; ++i) v[4 * n + i] = acc[ai][bj][m][n][i] * r;
                    if (pn == 11 && bj == 1 && wc == 1) {
                        float d[8];
#pragma unroll
                        for (int e = 0; e < 8; ++e) d[e] = softplus_f(v[e] + dt_bias[8 * fq + e]);
                        { const f32x4 dlo = {d[0], d[1], d[2], d[3]}; wt16f(DT + (size_t)row * 32 + 8 * fq, dlo); }
                        { const f32x4 dhi = {d[4], d[5], d[6], d[7]}; wt16f(DT + (size_t)row * 32 + 8 * fq + 4, dhi); }
                    } else {
                        wt16(U + (size_t)row * NU + col0 + bj * 128, pack8(v));
                    }
                    if (pn == 10 || (pn == 11 && bj == 0)) {
#pragma unroll
                        for (int e = 0; e < 8; ++e) sq += v[e] * v[e];
                    }
                }
                if (pn == 10 || pn == 11) {
                    sq += __shfl_xor(sq, 16); sq += __shfl_xor(sq, 32);
                    if (fq == 0) wt4f((pn == 10 ? qss : kvss) + (size_t)row * 4 + wc, sq);
                }
            }
    }
};
struct EpiQ {
    const unsigned char* WSB;
    bf16_t* O; const float* qss;
    __device__ __forceinline__ void operator()(const f32x4 (&acc)[2][2][4][2], const pg8::Unit& u, int wr, int wc, int fr, int fq) const {
        const int row0 = u.pm * 256 + wr * 64 + fr, col0 = u.pn * 256 + wc * 32 + 8 * fq;
        f32x4 rq[2][4];
#pragma unroll
        for (int ai = 0; ai < 2; ++ai)
#pragma unroll
            for (int m = 0; m < 4; ++m) rq[ai][m] = *(const f32x4*)(qss + (size_t)(row0 + ai * 128 + m * 16) * 4);
#pragma unroll
        for (int ai = 0; ai < 2; ++ai)
#pragma unroll
            for (int m = 0; m < 4; ++m) {
                const int row = row0 + ai * 128 + m * 16; const float r = rsqrtf(sum4q(rq[ai][m]) * (1.f / 256.f) + EPS);
#pragma unroll
                for (int bj = 0; bj < 2; ++bj) {
                    float v[8];
#pragma unroll
                    for (int n = 0; n < 2; ++n)
#pragma unroll
                        for (int i = 0; i < 4; ++i) v[4 * n + i] = acc[ai][bj][m][n][i] * r;
                    wt16(O + (size_t)row * 768 + col0 + bj * 128, pack8(v));
                }
            }
    }
};
struct EpiKV {
    const unsigned char* WSB;
    const bf16_t* U; const float* kvss; const float* khn; const float2* cs; bf16_t* Kf; bf16_t* Vt;
    __device__ __forceinline__ void operator()(const f32x4 (&acc)[2][2][4][2], const pg8::Unit& u, int wr, int wc, int fr, int fq) const {
        const int row0 = u.pm * 256 + wr * 64 + fr; const int pn = u.pn;
        f32x4 rq[2][4];
#pragma unroll
        for (int ai = 0; ai < 2; ++ai)
#pragma unroll
            for (int m = 0; m < 4; ++m) { const int rw = row0 + ai * 128 + m * 16; rq[ai][m] = *(const f32x4*)(kvss + (size_t)rw * 4); }
#pragma unroll
        for (int ai = 0; ai < 2; ++ai)
#pragma unroll
            for (int m = 0; m < 4; ++m) {
                const int row = row0 + ai * 128 + m * 16; const float rkv = rsqrtf(sum4q(rq[ai][m]) * (1.f / 128.f) + EPS);
                const int b = row >> 11, s = row & (SEQ - 1);
                float v[2][8];
#pragma unroll
                for (int bj = 0; bj < 2; ++bj)
#pragma unroll
                    for (int n = 0; n < 2; ++n)
#pragma unroll
                        for (int i = 0; i < 4; ++i) v[bj][4 * n + i] = acc[ai][bj][m][n][i] * rkv;
                if (pn < 2) {
                    const int head = 4 * pn + wc;
                    float ssn = 0.f;
#pragma unroll
                    for (int bj = 0; bj < 2; ++bj)
#pragma unroll
                        for (int e = 0; e < 8; ++e) ssn += v[bj][e] * v[bj][e];
                    float pe[8]; unpack8(*(const u32x4*)(U + (size_t)row * NU + UPE + 8 * fq), pe);
#pragma unroll
                    for (int e = 0; e < 8; ++e) ssn += pe[e] * pe[e];
                    ssn += __shfl_xor(ssn, 16); ssn += __shfl_xor(ssn, 32);
                    const float rk = rsqrtf(ssn * (1.f / 96.f) + EPS);
                    bf16_t* kb = Kf + ((size_t)(b * 8 + head) * SEQ + s) * 96;
#pragma unroll
                    for (int bj = 0; bj < 2; ++bj) {
                        float o[8];
#pragma unroll
                        for (int e = 0; e < 8; ++e) o[e] = v[bj][e] * rk * khn[32 * bj + 8 * fq + e];
                        wt16(kb + 32 * bj + 8 * fq, pack8(o));
                    }
                    float o[8];
#pragma unroll
                    for (int e = 0; e < 8; ++e) {
                        const float mine = pe[e] * rk * khn[64 + 8 * fq + e];
                        const float other = __shfl_xor(mine, 32);
                        const float2 c = cs[(size_t)row * 16 + ((8 * fq + e) & 15)];
                        o[e] = (fq < 2) ? (mine * c.x - other * c.y) : (other * c.y + mine * c.x);
                    }
                    wt16(kb + 64 + 8 * fq, pack8(o));
                } else {
                    const int head = 4 * (pn - 2) + wc;
                    bf16_t* vb = Vt + ((size_t)(b * 8 + head) * SEQ + s) * 64;
#pragma unroll
                    for (int bj = 0; bj < 2; ++bj) wt16(vb + 32 * bj + 8 * fq, pack8(v[bj]));
                }
            }
    }
};

struct CvtDesc { const float* W; const float* gain; bf16_t* WT; int N, K, srccol, destrow, k0, ld; };
__device__ __forceinline__ void cvt_load(const CvtDesc& d, float (&wv)[32], int lane) {
    if (d.W) {
#pragma unroll
        for (int i = 0; i < 32; ++i) { const int kk = 2 * i + (lane >> 5); wv[i] = __builtin_nontemporal_load(d.W + (size_t)(d.k0 + kk) * d.N + d.srccol + (lane & 31)); }
    } else {
#pragma unroll
        for (int i = 0; i < 32; ++i) wv[i] = 0.f;
    }
}
__device__ __forceinline__ void cvt_store(const unsigned char* WSB, const CvtDesc& d, const float (&wv)[32], LAS float* scr, int lane) {
#pragma unroll
    for (int i = 0; i < 32; ++i) scr[(2 * i + (lane >> 5)) * 33 + (lane & 31)] = wv[i];
    const int c = lane & 7;
    float g[8];
    if (d.gain) { const f32x4 g0 = *(const f32x4*)(d.gain + d.k0 + 8 * c), g1 = *(const f32x4*)(d.gain + d.k0 + 8 * c + 4);
        g[0] = g0[0]; g[1] = g0[1]; g[2] = g0[2]; g[3] = g0[3]; g[4] = g1[0]; g[5] = g1[1]; g[6] = g1[2]; g[7] = g1[3]; }
    else {
#pragma unroll
        for (int e = 0; e < 8; ++e) g[e] = 1.f;
    }
    asm volatile("s_waitcnt lgkmcnt(0)" ::: "memory");
#pragma unroll
    for (int j = 0; j < 4; ++j) { const int n = (lane >> 3) + 8 * j; const LAS float* sp = scr + (8 * c) * 33 + n;
        u32x4 o; o.x = cvt_pk_bf16(sp[0 * 33] * g[0], sp[1 * 33] * g[1]); o.y = cvt_pk_bf16(sp[2 * 33] * g[2], sp[3 * 33] * g[3]);
        o.z = cvt_pk_bf16(sp[4 * 33] * g[4], sp[5 * 33] * g[5]); o.w = cvt_pk_bf16(sp[6 * 33] * g[6], sp[7 * 33] * g[7]);
        wt16(d.WT + (size_t)(d.destrow + n) * d.ld + d.k0 + 8 * c, o); }
    asm volatile("s_waitcnt lgkmcnt(0)" ::: "memory");
}

__device__ __forceinline__ float wave_sum(float v) {
#pragma unroll
    for (int o = 1; o < 64; o <<= 1) v += __shfl_xor(v, o);
    return v;
}

__device__ __forceinline__ CvtDesc cvt_decode(CArgs a, int layer, int it) {
    unsigned char* wsw = a->ws + WS_W;
    constexpr int I_GU = 16 * 176, I_D = 44 * 32, I_IN = 16 * 144, I_UQ = 4 * 24, I_UKV = 2 * 32;
    CvtDesc d;
    int r = it;
    if (r < 2 * I_GU) {
        const int which = r / I_GU; r -= which * I_GU;
        const int db = r % 176, kb = r / 176, tile = db >> 3, sub = db & 7;
        const float* Wg = (which ? a->ffn2_wg : a->ffn1_wg) + (size_t)layer * DM * FF; const float* Wu = (which ? a->ffn2_wu : a->ffn1_wu) + (size_t)layer * DM * FF;
        d.W = sub < 4 ? Wg : Wu; d.gain = (which ? a->ffn2_norm : a->ffn1_norm) + layer * DM; d.WT = (bf16_t*)(wsw + (which ? W_GU2 : W_GU1));
        d.N = FF; d.K = DM; d.ld = DM; d.srccol = tile * 128 + (sub & 3) * 32; d.destrow = db * 32; d.k0 = kb * 64; return d;
    }
    r -= 2 * I_GU;
    if (r < 2 * I_D) {
        const int which = r / I_D; r -= which * I_D;
        const int db = r % 32, kb = r / 32;
        d.W = (which ? a->ffn2_wd : a->ffn1_wd) + (size_t)layer * FF * DM; d.gain = nullptr; d.WT = (bf16_t*)(wsw + (which ? W_D2 : W_D1));
        d.N = DM; d.K = FF; d.ld = HLD; d.srccol = db * 32; d.destrow = db * 32; d.k0 = kb * 64; return d;
    }
    r -= 2 * I_D;
    if (r < I_IN) {
        const int db = r % 144, kb = r / 144, uc = db * 32;
        int oc;
        if (uc < 2560) oc = uc; else if (uc < 2816) oc = 2592 + (uc - 2560); else if (uc < 2944) oc = 2848 + (uc - 2816); else if (uc < 2976) oc = 2976 + (uc - 2944);
        else if (uc < 3008) oc = 2560 + (uc - 2976); else if (uc < 3072) oc = -1; else oc = 3008 + (uc - 3072);
        d.W = oc >= 0 ? a->w_in + (size_t)layer * DM * DIN : nullptr; d.gain = a->mix_norm + layer * DM; d.WT = (bf16_t*)(wsw + W_IN);
        d.N = DIN; d.K = DM; d.ld = DM; d.srccol = oc; d.destrow = uc; d.k0 = kb * 64; return d;
    }
    r -= I_IN;
    if (r < I_UQ) {
        const int db = r % 24, kb = r / 24;
        d.W = a->mla_w_uq + (size_t)layer * 256 * 768; d.gain = a->mla_q_norm + layer * 256; d.WT = (bf16_t*)(wsw + W_UQ);
        d.N = 768; d.K = 256; d.ld = 256; d.srccol = db * 32; d.destrow = db * 32; d.k0 = kb * 64; return d;
    }
    r -= I_UQ;
    if (r < I_UKV) {
        const int db = r % 32, kb = r / 32, pn = db >> 3, bj = (db & 7) >> 2, wc = db & 3;
        d.W = a->mla_w_ukv + (size_t)layer * 128 * 1024; d.gain = a->mla_kv_norm + layer * 128; d.WT = (bf16_t*)(wsw + W_UKV);
        d.N = 1024; d.K = 128; d.ld = 128; d.srccol = (pn < 2) ? (4 * pn + wc) * 128 + 32 * bj : (4 * (pn - 2) + wc) * 128 + 64 + 32 * bj; d.destrow = db * 32; d.k0 = kb * 64; return d;
    }
    r -= I_UKV;
    {
        const int db = r % 32, kb = r / 32, k0 = kb * 64;
        d.W = a->w_out + (size_t)layer * 2048 * DM;
        d.gain = (k0 < 1024) ? a->ssd_norm + layer * 1024 : (k0 < 1536) ? a->mla_out_norm + layer * 512 - 1024 : a->conv_out_norm + layer * 512 - 1536;
        d.WT = (bf16_t*)(wsw + W_OUT); d.N = DM; d.K = 2048; d.ld = 2048; d.srccol = db * 32; d.destrow = db * 32; d.k0 = k0; return d;
    }
}

__device__ __forceinline__ void phase_convert(CArgs a, int layer, LAS unsigned char* lds, int G) {
    const unsigned char* WSB = a->ws;
    const int tid = ltid(), lane = tid & 63, wave = tid >> 6;
    LAS float* scr = (LAS float*)(lds + wave * 16384);
    const int gw = lbid() * NWAVES + wave, NGW = G * NWAVES;
    constexpr int NIT = 2 * 16 * 176 + 2 * 44 * 32 + 16 * 144 + 4 * 24 + 2 * 32 + 32 * 32;
    {
        int it = gw;
        float wv[32]; CvtDesc cur;
        if (it < NIT) { cur = cvt_decode(a, layer, it); cvt_load(cur, wv, lane); }
#pragma unroll 1
        while (it < NIT) {
            const int nxt = it + NGW;
            float wn[32]; CvtDesc nd = cur;
            if (nxt < NIT) { nd = cvt_decode(a, layer, nxt); cvt_load(nd, wn, lane); }
            cvt_store(WSB, cur, wv, scr, lane);
#pragma unroll
            for (int i = 0; i < 32; ++i) wv[i] = wn[i];
            cur = nd; it = nxt;
        }
    }
    if (layer == 0) {
        float* ctl = (float*)(a->ws + WS_CTL + CTL_ROWSS);
        bf16_t* xb = (bf16_t*)(a->ws + WS_XB);
        for (int m = gw; m < T; m += NGW) {
            const f32x4* xr = (const f32x4*)(a->x + (size_t)m * DM) + lane; float s = 0.f;
#pragma unroll
            for (int j = 0; j < 4; ++j) { const f32x4 v = xr[64 * j]; s += (v[0] * v[0] + v[1] * v[1]) + (v[2] * v[2] + v[3] * v[3]);
                u32x2 w; w.x = cvt_pk_bf16(v[0], v[1]); w.y = cvt_pk_bf16(v[2], v[3]); wt8(xb + (size_t)m * XLD + 256 * j + 4 * lane, w.x, w.y); }
            s = wave_sum(s);
            if (lane < 16) wt4f(ctl + (size_t)m * 16 + lane, (lane == 0) ? s : 0.f);
        }
        float2* cst = (float2*)(a->ws + WS_CS);
        for (int i = lbid() * NTHR + tid; i < T * 16; i += G * NTHR) {
            const int tok = i >> 4, j = i & 15;
            const float inv = powf(10000.f, -(float)j / 16.f);
            const float ang = (float)a->pos[tok] * inv;
            const double rev = (double)ang * 0.15915494309189535; const double fr = rev - rint(rev);
            wt8(cst + i, __float_as_uint(__builtin_amdgcn_cosf((float)fr)), __float_as_uint(__builtin_amdgcn_sinf((float)fr)));
        }
    }
}

constexpr int YS_LD = 72;
constexpr int SS_LD = 136;
constexpr int SS_CM = 0, SS_BW = 34816, SS_BT = 69632, SS_XT = 104448, SS_SB = 121856, SS_VEC = 139264;

template <int R>
__device__ __forceinline__ void conv_rows(const bf16_t* Ub, int s0, int c0, const float* cw, const float* cb, float (&out)[R][8]) {
    float w[5][8], bias[8];
#pragma unroll
    for (int k = 0; k < 5; ++k) { const f32x4 a0 = *(const f32x4*)(cw + k * 1536 + c0), a1 = *(const f32x4*)(cw + k * 1536 + c0 + 4);
        w[k][0] = a0[0]; w[k][1] = a0[1]; w[k][2] = a0[2]; w[k][3] = a0[3]; w[k][4] = a1[0]; w[k][5] = a1[1]; w[k][6] = a1[2]; w[k][7] = a1[3]; }
    { const f32x4 a0 = *(const f32x4*)(cb + c0), a1 = *(const f32x4*)(cb + c0 + 4);
      bias[0] = a0[0]; bias[1] = a0[1]; bias[2] = a0[2]; bias[3] = a0[3]; bias[4] = a1[0]; bias[5] = a1[1]; bias[6] = a1[2]; bias[7] = a1[3]; }
#pragma unroll
    for (int r = 0; r < R; ++r)
#pragma unroll
        for (int e = 0; e < 8; ++e) out[r][e] = bias[e];
#pragma unroll
    for (int i = 0; i < R + 4; ++i) {
        const int sp = s0 - 2 + i;
        float in[8];
        const int spc = sp < 0 ? 0 : (sp > SEQ - 1 ? SEQ - 1 : sp);
        u32x4 raw = *(const u32x4*)(Ub + (size_t)spc * NU + UX + c0);
        if (sp != spc) raw = (u32x4){0u, 0u, 0u, 0u};
        unpack8(raw, in);
#pragma unroll
        for (int r = 0; r < R; ++r) { const int k = i - r; if (k >= 0 && k < 5) {
#pragma unroll
            for (int e = 0; e < 8; ++e) out[r][e] += w[k][e] * in[e]; } }
    }
#pragma unroll
    for (int r = 0; r < R; ++r)
#pragma unroll
        for (int e = 0; e < 8; ++e) out[r][e] = silu_f(out[r][e]);
}

typedef short v4i16_t __attribute__((ext_vector_type(4)));
#define MFMA32(a, b, c) __builtin_amdgcn_mfma_f32_32x32x16_bf16((a), (b), (c), 0, 0, 0)
__device__ __forceinline__ int crow(int r, int hi) { return (r & 3) + 8 * (r >> 2) + 4 * hi; }


__device__ __forceinline__ void ssd_bc_slice(CArgs a, int layer, int item) {
    const unsigned char* WSB = a->ws;
    const int tid = ltid(), cgp = tid & 63, rb = tid >> 6, b = item >> 5, sl = item & 31;
    const bf16_t* Ub = (const bf16_t*)(a->ws + WS_U) + (size_t)b * SEQ * NU;
    bf16_t* XA = (bf16_t*)(a->ws + WS_XB) + (size_t)b * SEQ * 512;
    const float* cw = a->ssd_conv_w + (size_t)layer * 5 * 1536; const float* cb = a->ssd_conv_b + (size_t)layer * 1536;
    float o[8][8];
    const int s0 = sl * 64 + rb * 8;
    conv_rows<8>(Ub, s0, 1024 + cgp * 8, cw, cb, o);
#pragma unroll
    for (int r = 0; r < 8; ++r) wt16(XA + (size_t)(s0 + r) * 512 + cgp * 8, pack8(o[r]));
}
__device__ __forceinline__ void sub_arrive(unsigned* cnt) {
    asm volatile("s_waitcnt vmcnt(0)" ::: "memory");
    __syncthreads();
    if (threadIdx.x == 0) (void)__hip_atomic_fetch_add(cnt, 1u, __ATOMIC_RELAXED, __HIP_MEMORY_SCOPE_AGENT);
}
__device__ __forceinline__ void sub_wait(unsigned* cnt, unsigned want) {
    if (threadIdx.x == 0) {
        unsigned sp = 0;
        while (__hip_atomic_load(cnt, __ATOMIC_RELAXED, __HIP_MEMORY_SCOPE_AGENT) < want) { __builtin_amdgcn_s_sleep(1); if (++sp > (1u << 22)) break; }
        __builtin_amdgcn_fence(__ATOMIC_ACQUIRE, "agent");
        asm volatile("s_waitcnt vmcnt(0)" ::: "memory");
    }
    __syncthreads();
}
#define LDS_BARRIER() asm volatile("s_waitcnt lgkmcnt(0)\n\ts_barrier" ::: "memory")
__device__ __forceinline__ void ssd_item(CArgs a, int layer, int item, LAS unsigned char* lds) {
    const unsigned char* WSB = a->ws;
    const int tid0 = ltid();
    const int dir = item & 1, hd = (item >> 1) & 15, b = item >> 5, grp = hd >> 3;
    const bf16_t* Ub = (const bf16_t*)(a->ws + WS_U) + (size_t)b * SEQ * NU;
    const bf16_t* XA = (const bf16_t*)(a->ws + WS_XB) + (size_t)b * SEQ * 512;
    const float* DT = (const float*)(a->ws + WS_DT) + (size_t)b * SEQ * 32 + dir * 16 + hd;
    const int ystr = dir ? 1024 : 2048;
    bf16_t* yout = (dir ? (bf16_t*)(a->ws + WS_YF) : (bf16_t*)(a->ws + WS_Y)) + (size_t)b * SEQ * ystr + hd * 64;
    const float* cw = a->ssd_conv_w + (size_t)layer * 5 * 1536; const float* cb = a->ssd_conv_b + (size_t)layer * 1536;
    const float Aneg = -__expf(a->ssd_a_log[layer * 32 + dir * 16 + hd]) * 1.4426950408889634f;
    const float Dh = dir ? 0.f : a->ssd_d[layer * 16 + hd];
    LAS bf16_t* Cm = (LAS bf16_t*)(lds + SS_CM); LAS bf16_t* Bw = (LAS bf16_t*)(lds + SS_BW); LAS bf16_t* Bt = (LAS bf16_t*)(lds + SS_BT);
    LAS bf16_t* Xt = (LAS bf16_t*)(lds + SS_XT); LAS bf16_t* Sb = (LAS bf16_t*)(lds + SS_SB); LAS float* vec = (LAS float*)(lds + SS_VEC);
    LAS float* v_dA = vec, *v_cs = vec + 128, *v_ecs = vec + 256, *v_wgt = vec + 384, *v_dt = vec + 512;
    for (int i = tid0; i < 64 * SS_LD / 2; i += NTHR) ((LAS unsigned*)Sb)[i] = 0u;
    f32x16 Sacc; int tprev = 0;
#pragma unroll
    for (int r = 0; r < 16; ++r) Sacc[r] = 0.f;
    u32x4 pb[4], pc[4], px[6]; float pdt = 0.f;
#define SSD_PREFETCH(CC) do { const int tidp = ltid(); const int c_ = dir ? 15 - (CC) : (CC); const int t0_ = c_ * 128; \
        { const int cg8_ = tidp & 15, l0_ = (tidp >> 4) * 4; const bf16_t* xa_ = XA + (size_t)(t0_ + l0_) * 512 + grp * 128 + cg8_ * 8; \
          _Pragma("unroll") for (int r = 0; r < 4; ++r) { pb[r] = *(const u32x4*)(xa_ + (size_t)r * 512); pc[r] = *(const u32x4*)(xa_ + (size_t)r * 512 + 256); } } \
        { const int xg_ = tidp & 7, xl0_ = (tidp >> 3) * 2; \
          _Pragma("unroll") for (int i = 0; i < 6; ++i) { const int sp = t0_ + xl0_ - 2 + i; const int spc = sp < 0 ? 0 : (sp > SEQ - 1 ? SEQ - 1 : sp); \
              u32x4 raw = *(const u32x4*)(Ub + (size_t)spc * NU + UX + hd * 64 + xg_ * 8); if (sp != spc) raw = (u32x4){0u, 0u, 0u, 0u}; px[i] = raw; } } \
        pdt = (tidp < 128) ? DT[(size_t)(t0_ + tidp) * 32] : 0.f; } while (0)
    SSD_PREFETCH(0);
#pragma unroll 1
    for (int cc = 0; cc < 16; ++cc) {
        const int tid = ltid(), lane = tid & 63, wid = __builtin_amdgcn_readfirstlane(tid >> 6), r32 = lane & 31, hi = lane >> 5;
        const int yi = wid >> 1, yj = wid & 1;
        const int si = wid >> 2, sj = wid & 3;
        const int gi = wid >> 1, gj0 = (wid & 1) * 2;
        const int c = dir ? 15 - cc : cc; const int t0 = c * 128;
        const float dtv = pdt;
        if (tid < 128) v_dA[tid] = dtv * Aneg;
        LDS_BARRIER();
        if (cc > 0) {
#pragma unroll
            for (int i = 0; i < 2; ++i) { const int c2 = tid + 512 * i, row = c2 >> 3, part = c2 & 7;
                wt16(yout + (size_t)(tprev + row) * ystr + part * 8, *(const LAS u32x4*)(Bw + row * YS_LD + part * 8)); }
        }
        float etot;
        {
            float tot = 0.f, pre = 0.f;
            if (tid < 128) {
                const float mine = v_dA[tid];
                float sc = mine;
#pragma unroll
                for (int o = 1; o < 64; o <<= 1) { const float tt = __shfl_up(sc, o); sc += (lane >= o) ? tt : 0.f; }
                const float w0 = wave_sum(v_dA[lane]), w1 = wave_sum(v_dA[64 + lane]);
                tot = w0 + w1; pre = sc + (wid == 1 ? w0 : 0.f);
                if (dir) pre = tot - pre + mine;
                v_cs[tid] = pre; v_ecs[tid] = __builtin_amdgcn_exp2f(pre); v_wgt[tid] = dtv * __builtin_amdgcn_exp2f(tot - pre); v_dt[tid] = dtv;
                if (tid == 0) vec[640] = __builtin_amdgcn_exp2f(tot);
            }
        }
        LDS_BARRIER();
        etot = vec[640];
        {
            const int cg8 = tid & 15, rb = tid >> 4, l0 = rb * 4;
            float o[4][8];
            float wg[4];
#pragma unroll
            for (int r = 0; r < 4; ++r) { *(LAS u32x4*)(Cm + (l0 + r) * SS_LD + cg8 * 8) = pc[r]; *(LAS u32x4*)(Bw + (l0 + r) * SS_LD + cg8 * 8) = pb[r]; unpack8(pb[r], o[r]); wg[r] = v_wgt[l0 + r]; }
#pragma unroll
            for (int e = 0; e < 8; ++e) { u32x2 w; w.x = cvt_pk_bf16(o[0][e] * wg[0], o[1][e] * wg[1]); w.y = cvt_pk_bf16(o[2][e] * wg[2], o[3][e] * wg[3]);
                *(LAS u32x2*)(Bt + (cg8 * 8 + e) * SS_LD + l0) = w; }
            const int xg = tid & 7, xr = tid >> 3, xl0 = xr * 2;
            float ox[2][8];
            {
                const int c0 = hd * 64 + xg * 8;
                float bias[8];
                { const f32x4 a0 = *(const f32x4*)(cb + c0), a1 = *(const f32x4*)(cb + c0 + 4);
                  bias[0] = a0[0]; bias[1] = a0[1]; bias[2] = a0[2]; bias[3] = a0[3]; bias[4] = a1[0]; bias[5] = a1[1]; bias[6] = a1[2]; bias[7] = a1[3]; }
#pragma unroll
                for (int e = 0; e < 8; ++e) { ox[0][e] = bias[e]; ox[1][e] = bias[e]; }
#pragma unroll
                for (int k = 0; k < 5; ++k) {
                    const f32x4 a0 = *(const f32x4*)(cw + k * 1536 + c0), a1 = *(const f32x4*)(cw + k * 1536 + c0 + 4);
                    const float w[8] = {a0[0], a0[1], a0[2], a0[3], a1[0], a1[1], a1[2], a1[3]};
                    float i0[8], i1[8]; unpack8(px[k], i0); unpack8(px[k + 1], i1);
#pragma unroll
                    for (int e = 0; e < 8; ++e) { ox[0][e] += w[e] * i0[e]; ox[1][e] += w[e] * i1[e]; }
                }
#pragma unroll
                for (int e = 0; e < 8; ++e) { ox[0][e] = silu_f(ox[0][e]); ox[1][e] = silu_f(ox[1][e]); }
            }
#pragma unroll
            for (int e = 0; e < 8; ++e) *(LAS unsigned*)(Xt + (xg * 8 + e) * SS_LD + xl0) = cvt_pk_bf16(ox[0][e], ox[1][e]);
        }
        if (cc + 1 < 16) SSD_PREFETCH(cc + 1);
        LDS_BARRIER();
        f32x16 G0, G1;
#pragma unroll
        for (int r = 0; r < 16; ++r) { G0[r] = 0.f; G1[r] = 0.f; }
#pragma unroll
        for (int ks = 0; ks < 8; ++ks) {
            const bf16x8 af = *(const LAS bf16x8*)(Cm + (32 * gi + r32) * SS_LD + 16 * ks + 8 * hi);
            const bf16x8 b0 = *(const LAS bf16x8*)(Bw + (32 * gj0 + r32) * SS_LD + 16 * ks + 8 * hi);
            const bf16x8 b1 = *(const LAS bf16x8*)(Bw + (32 * (gj0 + 1) + r32) * SS_LD + 16 * ks + 8 * hi);
            G0 = MFMA32(af, b0, G0); G1 = MFMA32(af, b1, G1);
        }
        LDS_BARRIER();
        {
#pragma unroll
            for (int r = 0; r < 16; ++r) Sacc[r] *= etot;
#pragma unroll
            for (int ks = 0; ks < 8; ++ks) {
                const bf16x8 xa = *(const LAS bf16x8*)(Xt + (32 * si + r32) * SS_LD + 16 * ks + 8 * hi);
                const bf16x8 bb = *(const LAS bf16x8*)(Bt + (32 * sj + r32) * SS_LD + 16 * ks + 8 * hi);
                Sacc = MFMA32(xa, bb, Sacc);
            }
            const int s0i = 32 * gj0 + r32, s1i = s0i + 32;
            const float cs0 = v_cs[s0i], cs1 = v_cs[s1i], d0 = v_dt[s0i], d1 = v_dt[s1i];
#pragma unroll
            for (int r = 0; r < 16; ++r) {
                const int l = 32 * gi + crow(r, hi); const float csl = v_cs[l];
                const bool ok0 = dir ? (s0i >= l) : (s0i <= l), ok1 = dir ? (s1i >= l) : (s1i <= l);
                const float w0 = ok0 ? G0[r] * __builtin_amdgcn_exp2f(csl - cs0) * d0 : 0.f;
                const float w1 = ok1 ? G1[r] * __builtin_amdgcn_exp2f(csl - cs1) * d1 : 0.f;
                Bw[l * SS_LD + s0i] = f2bf(w0); Bw[l * SS_LD + s1i] = f2bf(w1);
            }
        }
        LDS_BARRIER();
        float yv[16];
        {
            f32x16 Yd, Yo;
#pragma unroll
            for (int r = 0; r < 16; ++r) { Yd[r] = 0.f; Yo[r] = 0.f; }
#pragma unroll
            for (int ks = 0; ks < 8; ++ks) {
                const bf16x8 wa = *(const LAS bf16x8*)(Bw + (32 * yi + r32) * SS_LD + 16 * ks + 8 * hi);
                const bf16x8 xb = *(const LAS bf16x8*)(Xt + (32 * yj + r32) * SS_LD + 16 * ks + 8 * hi);
                Yd = MFMA32(wa, xb, Yd);
                const bf16x8 ca = *(const LAS bf16x8*)(Cm + (32 * yi + r32) * SS_LD + 16 * ks + 8 * hi);
                const bf16x8 sb = *(const LAS bf16x8*)(Sb + (32 * yj + r32) * SS_LD + 16 * ks + 8 * hi);
                Yo = MFMA32(ca, sb, Yo);
            }
            const int p = 32 * yj + r32;
#pragma unroll
            for (int r = 0; r < 16; ++r) {
                const int l = 32 * yi + crow(r, hi);
                float y = Yd[r] + v_ecs[l] * Yo[r];
                y += Dh * bf2f(Xt[p * SS_LD + l]);
                yv[r] = y;
            }
        }
        LDS_BARRIER();
        {
            const int n = 32 * sj + r32;
#pragma unroll
            for (int r = 0; r < 16; ++r) Sb[(32 * si + crow(r, hi)) * SS_LD + n] = f2bf(Sacc[r]);
            const int p = 32 * yj + r32;
#pragma unroll
            for (int r = 0; r < 16; ++r) Bw[(32 * yi + crow(r, hi)) * YS_LD + p] = f2bf(yv[r]);
        }
        tprev = t0;
    }
    __syncthreads();
    {
        const int tid = ltid();
#pragma unroll
        for (int i = 0; i < 2; ++i) { const int c = tid + 512 * i, row = c >> 3, part = c & 7;
            wt16(yout + (size_t)(tprev + row) * ystr + part * 8, *(const LAS u32x4*)(Bw + row * YS_LD + part * 8)); }
    }
    __syncthreads();
}

constexpr int AT_KLD = 104, AT_VLD = 72;
constexpr int AT_K = 0, AT_KB = 64 * AT_KLD * 2, AT_V = 2 * AT_KB, AT_VB = 64 * AT_VLD * 2, AT_WS = AT_V + 2 * AT_VB, AT_ST = AT_WS + NWAVES * 64 * 4;
constexpr int AT_END = AT_ST + NWAVES * 32 * 68 * 4;
static_assert(AT_END <= LDS_BYTES && SS_VEC + 4096 <= LDS_BYTES, "LDS map");
constexpr float QK_SCALE = 0.10206207261596575f * 1.4426950408889634f;

__device__ __forceinline__ void attn_unit(CArgs a, int layer, int unit, LAS unsigned char* lds) {
    const int tid = ltid(), lane = tid & 63, wid = tid >> 6, r32 = lane & 31, hi = lane >> 5;
    const unsigned char* WSB = a->ws;
    const int qb = unit & 7, bh = unit >> 3, h = bh & 7, b = bh >> 3;
    const bf16_t* Kg = (const bf16_t*)(a->ws + WS_KF) + (size_t)bh * SEQ * 96;
    const bf16_t* Vg = (const bf16_t*)(a->ws + WS_VT) + (size_t)bh * SEQ * 64;
    const float2* cst = (const float2*)(a->ws + WS_CS);
    const float* qhn = a->mla_qhn + layer * 96;
    LAS float* wsf = (LAS float*)(lds + AT_WS) + wid * 64;
    const int qrow = b * SEQ + qb * 256 + wid * 32 + r32;
    bf16x8 qf[6]; float mref;
    {
        const bf16_t* qp = (const bf16_t*)(a->ws + WS_QR) + (size_t)qrow * 768 + h * 96;
        float q[6][8]; float ss = 0.f;
#pragma unroll
        for (int s = 0; s < 6; ++s) { unpack8(*(const u32x4*)(qp + 16 * s + 8 * hi), q[s]);
#pragma unroll
            for (int e = 0; e < 8; ++e) ss += q[s][e] * q[s][e]; }
        ss += __shfl_xor(ss, 32);
        const float rq = rsqrtf(ss * (1.f / 96.f) + EPS);
#pragma unroll
        for (int s = 0; s < 6; ++s)
#pragma unroll
            for (int e = 0; e < 8; ++e) q[s][e] *= rq * qhn[16 * s + 8 * hi + e];
#pragma unroll
        for (int e = 0; e < 8; ++e) { const float2 c = cst[(size_t)qrow * 16 + 8 * hi + e]; const float x1 = q[4][e], x2 = q[5][e];
            q[4][e] = x1 * c.x - x2 * c.y; q[5][e] = x1 * c.y + x2 * c.x; }
        float qn2 = 0.f;
#pragma unroll
        for (int s = 0; s < 6; ++s) {
#pragma unroll
            for (int e = 0; e < 8; ++e) { q[s][e] *= QK_SCALE; qn2 += q[s][e] * q[s][e]; }
            qf[s] = __builtin_bit_cast(bf16x8, pack8(q[s]));
        }
        qn2 += __shfl_xor(qn2, 32);
        const float* khn = a->mla_khn + layer * 96;
        float gm = fmaxf(fabsf(khn[lane]), fabsf(khn[64 + (lane & 31)]));
#pragma unroll
        for (int o = 1; o < 64; o <<= 1) gm = fmaxf(gm, __shfl_xor(gm, o));
        mref = 1.02f * sqrtf(qn2) * 9.797958971f * gm;
    }
    u32x4 kr0, kr1, vr;
    const int kc0 = tid, kc1 = tid + 512;
    constexpr int NT = SEQ / 64;
    auto gloadK = [&](int t) {
        const bf16_t* kt = Kg + (size_t)t * 64 * 96;
        kr0 = *(const u32x4*)(kt + kc0 * 8);
        kr1 = *(const u32x4*)(kt + (kc1 < 768 ? kc1 : 767) * 8);
    };
    auto gloadV = [&](int t) { vr = *(const u32x4*)(Vg + (size_t)t * 64 * 64 + tid * 8); };
    auto lstoreK = [&](int buf) {
        LAS bf16_t* Kl = (LAS bf16_t*)(lds + AT_K + buf * AT_KB);
        *(LAS u32x4*)(Kl + (kc0 / 12) * AT_KLD + (kc0 % 12) * 8) = kr0;
        if (kc1 < 768) *(LAS u32x4*)(Kl + (kc1 / 12) * AT_KLD + (kc1 % 12) * 8) = kr1;
    };
    auto lstoreV = [&](int buf) {
        LAS bf16_t* Vl = (LAS bf16_t*)(lds + AT_V + buf * AT_VB);
        *(LAS u32x4*)(Vl + (tid >> 3) * AT_VLD + (tid & 7) * 8) = vr;
    };
    f32x16 negm;
#pragma unroll
    for (int r = 0; r < 16; ++r) negm[r] = -mref;
    auto qk = [&](int buf, f32x16& p0, f32x16& p1) {
        const LAS bf16_t* Kl = (const LAS bf16_t*)(lds + AT_K + buf * AT_KB);
#pragma unroll
        for (int s = 0; s < 6; ++s) {
            const bf16x8 k0 = *(const LAS bf16x8*)(Kl + r32 * AT_KLD + 16 * s + 8 * hi);
            const bf16x8 k1 = *(const LAS bf16x8*)(Kl + (32 + r32) * AT_KLD + 16 * s + 8 * hi);
            if (s == 0) { p0 = MFMA32(k0, qf[0], negm); p1 = MFMA32(k1, qf[0], negm); }
            else { p0 = MFMA32(k0, qf[s], p0); p1 = MFMA32(k1, qf[s], p1); }
        }
    };
    __syncthreads();
    gloadK(0); gloadV(0); lstoreK(0); lstoreV(0); gloadK(1); lstoreK(1);
    __syncthreads();
    float lrun = 0.f;
    f32x16 o0, o1, pA0, pA1, pB0, pB1;
#pragma unroll
    for (int r = 0; r < 16; ++r) { o0[r] = 0.f; o1[r] = 0.f; }
    qk(0, pA0, pA1);
    auto tile = [&](int t, f32x16& c0, f32x16& c1, f32x16& n0, f32x16& n1) {
        const int buf = t & 1;
        gloadK(t + 2 < NT ? t + 2 : NT - 1); gloadV(t + 1 < NT ? t + 1 : NT - 1);
        const LAS bf16_t* Vl = (const LAS bf16_t*)(lds + AT_V + buf * AT_VB);
        qk(buf ^ 1, n0, n1);
        f32x16 p0, p1;
        float rs = 0.f;
#pragma unroll
        for (int r = 0; r < 16; ++r) { p0[r] = __builtin_amdgcn_exp2f(c0[r]); p1[r] = __builtin_amdgcn_exp2f(c1[r]); rs += p0[r] + p1[r]; }
        lrun += rs;
        bf16x8 pf[4];
#pragma unroll
        for (int s = 0; s < 2; ++s) {
            u32x4 w0, w1;
            w0.x = cvt_pk_bf16(p0[8 * s], p0[8 * s + 1]); w0.y = cvt_pk_bf16(p0[8 * s + 2], p0[8 * s + 3]); w0.z = cvt_pk_bf16(p0[8 * s + 4], p0[8 * s + 5]); w0.w = cvt_pk_bf16(p0[8 * s + 6], p0[8 * s + 7]);
            w1.x = cvt_pk_bf16(p1[8 * s], p1[8 * s + 1]); w1.y = cvt_pk_bf16(p1[8 * s + 2], p1[8 * s + 3]); w1.z = cvt_pk_bf16(p1[8 * s + 4], p1[8 * s + 5]); w1.w = cvt_pk_bf16(p1[8 * s + 6], p1[8 * s + 7]);
            pf[s] = __builtin_bit_cast(bf16x8, w0); pf[2 + s] = __builtin_bit_cast(bf16x8, w1);
        }
#pragma unroll
        for (int i = 0; i < 12; ++i) { __builtin_amdgcn_sched_group_barrier(0x008, 1, 0); __builtin_amdgcn_sched_group_barrier(0x002, 9, 0); }
#pragma unroll
        for (int s4 = 0; s4 < 4; ++s4) {
            const int kb = 32 * (s4 >> 1) + 16 * (s4 & 1) + 4 * hi;
            const LAS bf16_t* vrow = Vl + (kb - 4 * hi + 4 * hi + ((lane & 15) >> 2)) * AT_VLD + 16 * ((lane >> 4) & 1) + 4 * (lane & 3);
            const v4i16_t a0 = __builtin_amdgcn_ds_read_tr16_b64_v4i16((LAS v4i16_t*)(vrow)), a1 = __builtin_amdgcn_ds_read_tr16_b64_v4i16((LAS v4i16_t*)(vrow + 8 * AT_VLD));
            const v4i16_t c0 = __builtin_amdgcn_ds_read_tr16_b64_v4i16((LAS v4i16_t*)(vrow + 32)), c1 = __builtin_amdgcn_ds_read_tr16_b64_v4i16((LAS v4i16_t*)(vrow + 8 * AT_VLD + 32));
            const bf16x8 v0 = __builtin_shufflevector(a0, a1, 0, 1, 2, 3, 4, 5, 6, 7), v1 = __builtin_shufflevector(c0, c1, 0, 1, 2, 3, 4, 5, 6, 7);
            o0 = MFMA32(pf[s4], v0, o0);
            o1 = MFMA32(pf[s4], v1, o1);
        }
        lstoreK(buf); lstoreV(buf ^ 1);
        __syncthreads();
    };
#pragma unroll 1
    for (int t = 0; t < NT; t += 2) { tile(t, pA0, pA1, pB0, pB1); tile(t + 1, pB0, pB1, pA0, pA1); }
    lrun += __shfl_xor(lrun, 32);
    if (hi == 0) wsf[32 + r32] = 1.f / lrun;
    LAS float* stg = (LAS float*)(lds + AT_ST) + wid * 32 * 68;
#pragma unroll
    for (int r = 0; r < 16; ++r) { const int q = crow(r, hi); const float il = wsf[32 + q]; stg[q * 68 + r32] = o0[r] * il; stg[q * 68 + 32 + r32] = o1[r] * il; }
    {
        const int row = lane >> 1, half = lane & 1;
        float v[32]; float ss = 0.f;
#pragma unroll
        for (int i = 0; i < 8; ++i) { const f32x4 x = *(const LAS f32x4*)(stg + row * 68 + half * 32 + 4 * i); v[4 * i] = x[0]; v[4 * i + 1] = x[1]; v[4 * i + 2] = x[2]; v[4 * i + 3] = x[3];
            ss += (x[0] * x[0] + x[1] * x[1]) + (x[2] * x[2] + x[3] * x[3]); }
        ss += __shfl_xor(ss, 1);
        const float ro = rsqrtf(ss * (1.f / 64.f) + EPS);
        bf16_t* yp = (bf16_t*)(a->ws + WS_Y) + (size_t)(b * SEQ + qb * 256 + wid * 32 + row) * 2048 + 1024 + h * 64 + half * 32;
#pragma unroll
        for (int i = 0; i < 4; ++i) { u32x4 w; w.x = cvt_pk_bf16(v[8 * i] * ro, v[8 * i + 1] * ro); w.y = cvt_pk_bf16(v[8 * i + 2] * ro, v[8 * i + 3] * ro);
            w.z = cvt_pk_bf16(v[8 * i + 4] * ro, v[8 * i + 5] * ro); w.w = cvt_pk_bf16(v[8 * i + 6] * ro, v[8 * i + 7] * ro); wt16(yp + 8 * i, w); }
    }
}

__device__ __forceinline__ void conv_mixer_rows(CArgs a, int layer, int G) {
    const int lane = ltid() & 63, wave = ltid() >> 6;
    const int gw = lbid() * NWAVES + wave, NGW = G * NWAVES;
    const unsigned char* WSB = a->ws;
    const bf16_t* U = (const bf16_t*)(a->ws + WS_U); bf16_t* Y = (bf16_t*)(a->ws + WS_Y);
    const float* cw = a->conv_w + (size_t)layer * 3 * 512;
    const int c0 = lane * 8;
    float w[3][8];
#pragma unroll
    for (int k = 0; k < 3; ++k) { const f32x4 a0 = *(const f32x4*)(cw + k * 512 + c0), a1 = *(const f32x4*)(cw + k * 512 + c0 + 4);
        w[k][0] = a0[0]; w[k][1] = a0[1]; w[k][2] = a0[2]; w[k][3] = a0[3]; w[k][4] = a1[0]; w[k][5] = a1[1]; w[k][6] = a1[2]; w[k][7] = a1[3]; }
    auto load = [&](int row, u32x4 (&raw)[7]) {
        const int s = row & (SEQ - 1);
#pragma unroll
        for (int k = 0; k < 3; ++k) {
            const int sp = s + k - 1; const int rr = (sp >= 0 && sp < SEQ) ? row + k - 1 : row;
            const bf16_t* ur = U + (size_t)rr * NU;
            u32x4 h = *(const u32x4*)(ur + UCH + c0), c = *(const u32x4*)(ur + UCC + c0);
            if (!(sp >= 0 && sp < SEQ)) { h = (u32x4){0u, 0u, 0u, 0u}; c = (u32x4){0u, 0u, 0u, 0u}; }
            raw[2 * k] = h; raw[2 * k + 1] = c;
        }
        raw[6] = *(const u32x4*)(U + (size_t)row * NU + UCB + c0);
    };
    auto finish = [&](int row, const u32x4 (&raw)[7]) {
        float accv[8];
#pragma unroll
        for (int e = 0; e < 8; ++e) accv[e] = 0.f;
#pragma unroll
        for (int k = 0; k < 3; ++k) { float ch[8], cc[8]; unpack8(raw[2 * k], ch); unpack8(raw[2 * k + 1], cc);
#pragma unroll
            for (int e = 0; e < 8; ++e) accv[e] += w[k][e] * (cc[e] * ch[e]); }
        float cbv[8]; unpack8(raw[6], cbv);
        float ss = 0.f;
#pragma unroll
        for (int e = 0; e < 8; ++e) { accv[e] *= cbv[e]; ss += accv[e] * accv[e]; }
        ss += __shfl_xor(ss, 1); ss += __shfl_xor(ss, 2); ss += __shfl_xor(ss, 4);
        const float r = rsqrtf(ss * (1.f / 64.f) + EPS);
#pragma unroll
        for (int e = 0; e < 8; ++e) accv[e] *= r;
        wt16(Y + (size_t)row * 2048 + 1536 + c0, pack8(accv));
    };
    for (int row = gw; row < T; row += 2 * NGW) {
        const int row2 = row + NGW;
        u32x4 ra[7], rb[7];
        load(row, ra);
        if (row2 < T) load(row2, rb);
        finish(row, ra);
        if (row2 < T) finish(row2, rb);
    }
}
__device__ __forceinline__ void ssd_combine_rows(CArgs a, int G) {
    const int lane = ltid() & 63, wave = ltid() >> 6;
    const int gw = lbid() * NWAVES + wave, NGW = G * NWAVES;
    const unsigned char* WSB = a->ws;
    const bf16_t* U = (const bf16_t*)(a->ws + WS_U); bf16_t* Y = (bf16_t*)(a->ws + WS_Y);
    const bf16_t* yb = (const bf16_t*)(a->ws + WS_YF);
    const int c0 = lane * 16;
    auto load = [&](int row, u32x4 (&raw)[6]) {
#pragma unroll
        for (int hf = 0; hf < 2; ++hf) { raw[3 * hf] = *(const u32x4*)(Y + (size_t)row * 2048 + c0 + 8 * hf); raw[3 * hf + 1] = *(const u32x4*)(yb + (size_t)row * 1024 + c0 + 8 * hf);
            raw[3 * hf + 2] = *(const u32x4*)(U + (size_t)row * NU + UZ + c0 + 8 * hf); }
    };
    auto finish = [&](int row, const u32x4 (&raw)[6]) {
        float g[16]; float ss = 0.f;
#pragma unroll
        for (int hf = 0; hf < 2; ++hf) {
            float f[8], bb[8], z[8];
            unpack8(raw[3 * hf], f); unpack8(raw[3 * hf + 1], bb); unpack8(raw[3 * hf + 2], z);
#pragma unroll
            for (int e = 0; e < 8; ++e) { const float y = (f[e] + bb[e]) * silu_f(z[e]); g[8 * hf + e] = y; ss += y * y; }
        }
        ss += __shfl_xor(ss, 1); ss += __shfl_xor(ss, 2); ss += __shfl_xor(ss, 4); ss += __shfl_xor(ss, 8); ss += __shfl_xor(ss, 16);
        const float r = rsqrtf(ss * (1.f / 512.f) + EPS);
        float o0[8], o1[8];
#pragma unroll
        for (int e = 0; e < 8; ++e) { o0[e] = g[e] * r; o1[e] = g[8 + e] * r; }
        wt16(Y + (size_t)row * 2048 + c0, pack8(o0)); wt16(Y + (size_t)row * 2048 + c0 + 8, pack8(o1));
    };
    for (int row = gw; row < T; row += 2 * NGW) {
        const int row2 = row + NGW;
        u32x4 ra[6], rb[6];
        load(row, ra);
        if (row2 < T) load(row2, rb);
        finish(row, ra);
        if (row2 < T) finish(row2, rb);
    }
}

#define XB_TMO      128
#define XB_XCNT(j)  (256  + 64 * (j))
#define XB_XSUB(j)  (1280 + 64 * (j))
#define XB_XGEN(j)  (2304 + 64 * (j))
#define XB_TOP      3328
#define XB_TOPGEN   3392
#define XCD_BAR_WORDS 3456
#define XB_SPIN_CAP (1u << 20)
__device__ __forceinline__ unsigned xb_ld(unsigned* p)              { return __hip_atomic_load(p, __ATOMIC_RELAXED, __HIP_MEMORY_SCOPE_AGENT); }
__device__ __forceinline__ unsigned xb_add(unsigned* p, unsigned v) { return __hip_atomic_fetch_add(p, v, __ATOMIC_RELAXED, __HIP_MEMORY_SCOPE_AGENT); }
__device__ __forceinline__ unsigned xb_xcc_id() { return (unsigned)__builtin_amdgcn_s_getreg((3 << 11) | 20) & 0xFu; }
#define XB_SPIN(cond, bar) do { unsigned _sp = 0; while (cond) { __builtin_amdgcn_s_sleep(1); \
    if ((++_sp & 255u) == 0u) { if (xb_ld(&(bar)[XB_TMO])) break; if (_sp > XB_SPIN_CAP) { atomicAdd(&(bar)[XB_TMO], 1u); break; } } } } while (0)
struct XcdBarrier { unsigned* bar; unsigned x; volatile LAS unsigned* st; };
__device__ __forceinline__ XcdBarrier xcd_barrier_post(unsigned* bar, volatile LAS unsigned* st) {
    XcdBarrier b; b.bar = bar; b.x = xb_xcc_id(); b.st = st;
    if (threadIdx.x == 0) (void)xb_add(&bar[XB_XCNT(b.x)], 1u);
    return b;
}
__device__ __forceinline__ void xcd_barrier_complete(unsigned* bar, unsigned x, unsigned& nloc, unsigned& nx) {
    const unsigned G = gridDim.x * gridDim.y * gridDim.z;
    unsigned sum, cnt, mine, sp = 0u;
    for (;;) {
        sum = 0u; cnt = 0u; mine = 0u;
#pragma unroll
        for (unsigned j = 0; j < 16; ++j) { const unsigned c = xb_ld(&bar[XB_XCNT(j)]); sum += c; cnt += (c > 0u) ? 1u : 0u; mine = (j == x) ? c : mine; }
        if (sum == G) break;
        __builtin_amdgcn_s_sleep(1);
        if ((++sp & 255u) == 0u) { if (xb_ld(&bar[XB_TMO])) break; if (sp > XB_SPIN_CAP) { atomicAdd(&bar[XB_TMO], 1u); break; } }
    }
    nloc = mine > 0u ? mine : 1u; nx = cnt > 0u ? cnt : 1u;
}
__device__ __forceinline__ void xcd_barrier(const XcdBarrier& b) {
    asm volatile("s_waitcnt vmcnt(0)" ::: "memory");
    __syncthreads();
    if (threadIdx.x == 0) {
        unsigned* bar = b.bar;
        __builtin_amdgcn_s_waitcnt(0);
        unsigned nloc = b.st[0], nx = b.st[1];
        if (nloc == 0u) { xcd_barrier_complete(bar, b.x, nloc, nx); b.st[0] = nloc; b.st[1] = nx; }
        const unsigned old = xb_add(&bar[XB_XSUB(b.x)], 1u);
        const unsigned gen = old / nloc;
        if (old + 1u == (gen + 1u) * nloc) {
            const unsigned og = xb_add(&bar[XB_TOP], 1u);
            const unsigned tg = og / nx;
            if (og + 1u == (tg + 1u) * nx) xb_add(&bar[XB_TOPGEN], 1u);
            else XB_SPIN(xb_ld(&bar[XB_TOPGEN]) == tg, bar);
            __builtin_amdgcn_fence(__ATOMIC_ACQUIRE, "agent");
            xb_add(&bar[XB_XGEN(b.x)], 1u);
            asm volatile("s_waitcnt vmcnt(0)" ::: "memory");
        } else {
            XB_SPIN(xb_ld(&bar[XB_XGEN(b.x)]) == gen, bar);
            __builtin_amdgcn_fence(__ATOMIC_ACQUIRE, "agent");
            asm volatile("s_waitcnt vmcnt(0)" ::: "memory");
        }
    }
    __syncthreads();
}
#ifndef PH_MASK
#define PH_MASK 0xff
#endif
#define PH_EN(i) ((PH_MASK >> (i)) & 1)
#ifndef P4_MASK
#define P4_MASK 0xf
#endif
#define P4_EN(i) ((P4_MASK >> (i)) & 1)
constexpr int PH_PER_LAYER = 9, N_PHASES = DEPTH * PH_PER_LAYER;

__global__ void __launch_bounds__(NTHR, 2) mk_fwd(Args a_by_value) {
    extern __shared__ __attribute__((aligned(16))) unsigned char lds_raw[];
    LAS unsigned char* lds = (LAS unsigned char*)lds_raw;
    cg::grid_group grid = cg::this_grid();
    const int G = gridDim.x;
    unsigned char* ws; { CArgs a0 = get_args(); ws = a0->ws; }
    const int ph_lo = get_args()->ph_lo, ph_hi = get_args()->ph_hi;
    float* rowss = (float*)(ws + WS_CTL + CTL_ROWSS);
    bf16_t* U = (bf16_t*)(ws + WS_U); bf16_t* Hb = U; bf16_t* XB = (bf16_t*)(ws + WS_XB); bf16_t* Y = (bf16_t*)(ws + WS_Y);
    unsigned char* wsw = ws + WS_W;
    volatile LAS unsigned* xst = (volatile LAS unsigned*)(lds + LDS_BYTES - 16);
    if (threadIdx.x < 4) xst[threadIdx.x] = 0u;
    __syncthreads();
    XcdBarrier xbar; xbar.bar = (unsigned*)(ws + WS_BAR); xbar.x = 0; xbar.st = xst;
    if (USE_XCD_BAR && ph_hi - ph_lo > 1) xbar = xcd_barrier_post((unsigned*)(ws + WS_BAR), xst);
    for (int ph = ph_lo; ph < ph_hi; ++ph) {
        CArgs a = get_args(); const int bid = lbid();
        const int layer = ph / PH_PER_LAYER, k = ph % PH_PER_LAYER;
        if (PH_EN(0) && k == 0) {
            for (int rep = 0; rep < REP_CV; ++rep) phase_convert(a, layer, lds, G);
        } else if (PH_EN(1) && (k == 1 || k == 7)) {
            pg8::Gemm g{XB, (const bf16_t*)(wsw + (k == 1 ? W_GU1 : W_GU2)), T, 2 * FF, DM, XLD, DM}; pg8::StaticOrder S; S.init(T, 2 * FF, G, bid);
            EpiSwiglu E{ws, Hb, rowss};
            for (int rep = 0; rep < REP_GU; ++rep) pg8::gemm_phase<EpiSwiglu, pg8::StaticOrder, true>(lds, g, S, E);
        } else if (PH_EN(2) && (k == 2 || k == 8)) {
            pg8::Gemm g{Hb, (const bf16_t*)(wsw + (k == 2 ? W_D1 : W_D2)), T, DM, FF, HLD, HLD}; pg8::StaticOrder S; S.init(T, DM, G, bid);
            EpiResid E{ws, (layer == 0 && k == 2) ? a->x : a->out, a->out, XB, rowss, 0.5f};
            pg8::gemm_phase<EpiResid, pg8::StaticOrder, false>(lds, g, S, E);
        } else if (PH_EN(3) && k == 3) {
            pg8::Gemm g{XB, (const bf16_t*)(wsw + W_IN), T, NU, DM, XLD, DM}; pg8::StaticOrder S; S.init(T, NU, G, bid);
            EpiU E{ws, U, rowss, (float*)(ws + WS_CTL + CTL_QSS), (float*)(ws + WS_CTL + CTL_KVSS),
                   (float*)(ws + WS_DT), a->ssd_dt_bias + layer * 32};
            for (int rep = 0; rep < REP_IN; ++rep) pg8::gemm_phase<EpiU, pg8::StaticOrder, true>(lds, g, S, E);
        } else if (PH_EN(4) && k == 4) {
            unsigned* subc = (unsigned*)(ws + WS_BAR) + XCD_BAR_WORDS + 64 * (layer * 8);
            for (int item = bid; item < 256; item += G) { ssd_bc_slice(a, layer, item); sub_arrive(subc + 64 * (item >> 5)); }
            for (int rep4 = 0; rep4 < REP_P4R; ++rep4) {
            if (P4_EN(1)) {
                pg8::Gemm g{U + UQ, (const bf16_t*)(wsw + W_UQ), T, 768, 256, NU, 256}; pg8::StaticOrder S; S.init(T, 768, G, bid);
                EpiQ E{ws, (bf16_t*)(ws + WS_QR), (const float*)(ws + WS_CTL + CTL_QSS)};
                pg8::gemm_phase<EpiQ, pg8::StaticOrder, false>(lds, g, S, E);
            }
            if (P4_EN(2)) {
                pg8::Gemm g{U + UKV, (const bf16_t*)(wsw + W_UKV), T, 1024, 128, NU, 128}; pg8::StaticOrder S; S.init(T, 1024, G, bid);
                EpiKV E{ws, U, (const float*)(ws + WS_CTL + CTL_KVSS), a->mla_khn + layer * 96, (const float2*)(ws + WS_CS), (bf16_t*)(ws + WS_KF), (bf16_t*)(ws + WS_VT)};
                pg8::gemm_phase<EpiKV, pg8::StaticOrder, false>(lds, g, S, E);
            }
            if (P4_EN(3)) conv_mixer_rows(a, layer, G);
            }
            for (int item = bid; item < 256; item += G) { sub_wait(subc + 64 * (item >> 5), 32u); ssd_item(a, layer, item, lds); }
        } else if (PH_EN(5) && k == 5) {
            const int vcu = (G % 8 == 0) ? (bid % 8) * (G / 8) + bid / 8 : bid;
            for (int rep = 0; rep < REP_ATT; ++rep) for (int unit = vcu; unit < 512; unit += G) attn_unit(a, layer, (unit & 255) * 2 + (unit >> 8), lds);
            for (int rep5 = 0; rep5 < REP_CMB; ++rep5) ssd_combine_rows(a, G);
        } else if (PH_EN(6) && k == 6) {
            pg8::Gemm g{Y, (const bf16_t*)(wsw + W_OUT), T, DM, 2048, 2048, 2048}; pg8::StaticOrder S; S.init(T, DM, G, bid);
            EpiResid E{ws, a->out, a->out, XB, rowss, 1.0f};
            pg8::gemm_phase<EpiResid, pg8::StaticOrder, false>(lds, g, S, E);
        }
#if USE_XCD_BAR
        if (ph + 1 < ph_hi) xcd_barrier(xbar);
        if (ph_hi < 0) grid.sync();
#else
        if (ph + 1 < ph_hi) {
            asm volatile("s_waitcnt vmcnt(0)" ::: "memory");
            grid.sync();
            __builtin_amdgcn_fence(__ATOMIC_ACQUIRE, "agent");
        }
#endif
    }
}

extern "C" void kernel_launch(void* const* d_in, const int* in_sizes, int n_in, void* d_out, int out_size, void* d_ws, size_t ws_size, hipStream_t stream) {
    static int grid = 0;
    if (grid == 0) {
        if (n_in != 28 || out_size != T * DM || ws_size < WS_END) { fprintf(stderr, "kernel_launch: bad shapes (n_in %d out %d ws %zu need %zu)\n", n_in, out_size, ws_size, (size_t)WS_END); grid = -1; return; }
        if (hipFuncSetAttribute((const void*)mk_fwd, hipFuncAttributeMaxDynamicSharedMemorySize, LDS_BYTES) != hipSuccess) { fprintf(stderr, "kernel_launch: hipFuncSetAttribute failed\n"); grid = -1; return; }
        int dev = 0, cus = 0, per_cu = 0;
        hipGetDevice(&dev); hipDeviceGetAttribute(&cus, hipDeviceAttributeMultiprocessorCount, dev);
        hipOccupancyMaxActiveBlocksPerMultiprocessor(&per_cu, (const void*)mk_fwd, NTHR, LDS_BYTES);
        if (per_cu < 1) { fprintf(stderr, "kernel_launch: occupancy query says %d blocks/CU\n", per_cu); per_cu = 1; }
        (void)hipGetLastError();
        grid = cus;
    }
    if (grid < 0) return;
    Args a{};
    a.x = (const float*)d_in[0]; a.pos = (const int*)d_in[1];
    a.ffn1_norm = (const float*)d_in[2]; a.ffn1_wg = (const float*)d_in[3]; a.ffn1_wu = (const float*)d_in[4]; a.ffn1_wd = (const float*)d_in[5];
    a.mix_norm = (const float*)d_in[6]; a.w_in = (const float*)d_in[7]; a.ssd_conv_w = (const float*)d_in[8]; a.ssd_conv_b = (const float*)d_in[9];
    a.ssd_dt_bias = (const float*)d_in[10]; a.ssd_a_log = (const float*)d_in[11]; a.ssd_d = (const float*)d_in[12]; a.ssd_norm = (const float*)d_in[13];
    a.mla_q_norm = (const float*)d_in[14]; a.mla_w_uq = (const float*)d_in[15]; a.mla_kv_norm = (const float*)d_in[16]; a.mla_w_ukv = (const float*)d_in[17];
    a.mla_qhn = (const float*)d_in[18]; a.mla_khn = (const float*)d_in[19]; a.mla_out_norm = (const float*)d_in[20]; a.conv_w = (const float*)d_in[21];
    a.conv_out_norm = (const float*)d_in[22]; a.w_out = (const float*)d_in[23]; a.ffn2_norm = (const float*)d_in[24]; a.ffn2_wg = (const float*)d_in[25];
    a.ffn2_wu = (const float*)d_in[26]; a.ffn2_wd = (const float*)d_in[27];
    a.out = (float*)d_out; a.ws = (unsigned char*)d_ws;
#if MK_MULTI
    for (int ph = 0; ph < N_PHASES; ++ph) { a.ph_lo = ph; a.ph_hi = ph + 1; hipLaunchKernelGGL(mk_fwd, dim3(grid), dim3(NTHR), LDS_BYTES, stream, a); }
#else
    a.ph_lo = 0; a.ph_hi = N_PHASES;
    if (hipMemsetAsync((char*)d_ws + WS_BAR, 0, (XCD_BAR_WORDS + 64 * 32) * 4, stream) != hipSuccess) { fprintf(stderr, "kernel_launch: memset of barrier words failed\n"); return; }
    void* args[] = {&a};
    hipError_t e = hipLaunchCooperativeKernel((const void*)mk_fwd, dim3(grid), dim3(NTHR), args, LDS_BYTES, stream);
    if (e != hipSuccess) fprintf(stderr, "cooperative launch failed: %s (grid %d)\n", hipGetErrorString(e), grid);
#endif
}
```

```cpp
#include <hip/hip_runtime.h>
#include <hip/hip_cooperative_groups.h>
#include <cstdio>
#include <cstdint>
namespace cg = cooperative_groups;
__device__ __forceinline__ int ltid() { int t = threadIdx.x; asm volatile("" : "+v"(t)); return t; }
__device__ __forceinline__ int lbid() { int t = blockIdx.x; asm volatile("" : "+s"(t)); return t; }

#ifndef USE_XCD_BAR
#define USE_XCD_BAR 1
#endif
#ifndef REP_SSD
#define REP_SSD 1
#endif
#ifndef REP_ATT
#define REP_ATT 1
#endif
#ifndef REP_GU
#define REP_GU 1
#endif
#ifndef REP_IN
#define REP_IN 1
#endif
#ifndef REP_CV
#define REP_CV 1
#endif
#ifndef REP_P4R
#define REP_P4R 1
#endif
#ifndef REP_CMB
#define REP_CMB 1
#endif
#ifndef MK_MULTI
#define MK_MULTI 0
#endif

namespace pg8 {
#define PG8_LAS __attribute__((address_space(3)))
typedef unsigned short bf16_t;
typedef short bf16x8 __attribute__((ext_vector_type(8)));
typedef float f32x4 __attribute__((ext_vector_type(4)));
typedef unsigned u32x4 __attribute__((ext_vector_type(4)));
constexpr int BM = 256, BK = 64, HALF = 128, HTB = HALF * BK * 2, STAGE_BYTES = 8 * HTB, NXCD = 8, WGM = 8;

__host__ __device__ __forceinline__ int lds_byte(int r, int c) { const int st = (r >> 4) * 2 + (c >> 5), rr = r & 15, cc = c & 31, ob = rr * 64 + cc * 2; return st * 1024 + (ob ^ (((ob >> 9) & 1) << 5)); }
__host__ __device__ __forceinline__ void stage_rc(int b, int& R, int& C) { const int st = b / 1024, sb = b % 1024, swz = sb ^ (((sb >> 9) & 1) << 5); R = (st >> 1) * 16 + swz / 64; C = (st & 1) * 32 + (swz % 64) / 2; }
__host__ __device__ __forceinline__ int perm32(int rho) { const int n = rho >> 4, i = rho & 15; return 8 * (i >> 2) + 4 * n + (i & 3); }

struct Unit { int pm, pn; };
struct Gemm { const bf16_t* A; const bf16_t* Bt; int M, N, K, lda, ldb; };

struct StaticOrder {
    int nM, nN, nwg, G, c;
    __host__ __device__ void init(int M, int N, int G_, int c_) { nM = M / BM; nN = N / BM; nwg = nM * nN; G = G_; c = c_; }
    __host__ __device__ bool next(int i, Unit& u) const {
        const long L = (long)i * G + c; if (L >= nwg) return false;
        int wgid = (int)L; { const int q = nwg / NXCD, r = nwg % NXCD, xcd = wgid % NXCD, off = wgid / NXCD; wgid = (xcd < r ? xcd * (q + 1) : r * (q + 1) + (xcd - r) * q) + off; }
        const int nig = WGM * nN, gid = wgid / nig, fm = gid * WGM, gsz = (nM - fm) < WGM ? (nM - fm) : WGM;
        u.pm = fm + ((wgid % nig) % gsz); u.pn = (wgid % nig) / gsz; return true;
    }
};

typedef float f32x2_t __attribute__((ext_vector_type(2))); typedef __bf16 bf16x2_t __attribute__((ext_vector_type(2)));
__device__ __forceinline__ unsigned cvt_pk_bf16(float lo, float hi) { f32x2_t v = {lo, hi}; bf16x2_t b = __builtin_convertvector(v, bf16x2_t); return __builtin_bit_cast(unsigned, b); }

template <class Epi, class Sched, bool ALIGN_EPI>
__device__ __forceinline__ void gemm_phase(PG8_LAS unsigned char* lds, const Gemm g, const Sched& S, const Epi& E) {
    const int tid = ltid(), wid = __builtin_amdgcn_readfirstlane(tid >> 6), lane = tid & 63, wr = wid >> 2, wc = wid & 3, fr = lane & 15, fq = lane >> 4;
    int K = g.K; asm volatile("" : "+s"(K)); const int nt = K / BK;
    unsigned voffA[2], voffB[2];
#pragma unroll
    for (int i = 0; i < 2; ++i) { int R, C; stage_rc(tid * 16 + i * 8192, R, C); const int Rb = (R & ~31) + perm32(R & 31);
        voffA[i] = (unsigned)(R * g.lda + C) * 2u; voffB[i] = (unsigned)(Rb * g.ldb + C) * 2u; }
    const size_t kstep = (size_t)(BK * 2);
    const size_t hstepA = (size_t)HALF * g.lda * 2, hstepB = (size_t)HALF * g.ldb * 2;
    const size_t tstepA = 2 * hstepA, tstepB = 2 * hstepB;
    const unsigned ldsw = (unsigned)wid * 1024u;
    const int aoff = lds_byte(wr * 64 + fr, fq * 8), boff = lds_byte(wc * 32 + fr, fq * 8);
#define PG8_SA(b, h) (((b) * 2 + (h)) * HTB)
#define PG8_SB(b, h) ((4 + (b) * 2 + (h)) * HTB)
#define PG8_STAGE(bufoff, gbase, voff) do { _Pragma("unroll") for (int _i = 0; _i < 2; ++_i) \
        __builtin_amdgcn_global_load_lds((const unsigned*)((const char*)(gbase) + (voff)[_i]), (PG8_LAS unsigned*)(lds + (bufoff) + ldsw + _i * 8192), 16, 0, 0); } while (0)
#define PG8_LDA(dst, b, h) do { _Pragma("unroll") for (int m = 0; m < 4; ++m) _Pragma("unroll") for (int k = 0; k < 2; ++k) dst[m][k] = *(const PG8_LAS bf16x8*)(lds + PG8_SA(b, h) + aoff + m * 2048 + k * 1024); } while (0)
#define PG8_LDB(dst, b, h) do { _Pragma("unroll") for (int n = 0; n < 2; ++n) _Pragma("unroll") for (int k = 0; k < 2; ++k) dst[n][k] = *(const PG8_LAS bf16x8*)(lds + PG8_SB(b, h) + boff + n * 2048 + k * 1024); } while (0)
#define PG8_MMA(ai, bj, At, Bt) do { __builtin_amdgcn_s_setprio(1); _Pragma("unroll") for (int m = 0; m < 4; ++m) _Pragma("unroll") for (int n = 0; n < 2; ++n) _Pragma("unroll") for (int k = 0; k < 2; ++k) \
        acc[ai][bj][m][n] = __builtin_amdgcn_mfma_f32_16x16x32_bf16(Bt[n][k], At[m][k], acc[ai][bj][m][n], 0, 0, 0); __builtin_amdgcn_s_setprio(0); } while (0)
#define PG8_WAIT_V(n) asm volatile("s_waitcnt vmcnt(" #n ")" ::: "memory")
#define PG8_WAIT_L(n) asm volatile("s_waitcnt lgkmcnt(" #n ")" ::: "memory")
#define PG8_BAR __builtin_amdgcn_s_barrier()
#define PG8_SCHED __builtin_amdgcn_sched_barrier(0)
    Unit cur, nxt; int ui = 0;
    if (!S.next(0, cur)) return;
    f32x4 acc[2][2][4][2];
#pragma unroll
    for (int a = 0; a < 2; ++a)
#pragma unroll
        for (int b = 0; b < 2; ++b)
#pragma unroll
            for (int m = 0; m < 4; ++m)
#pragma unroll
                for (int n = 0; n < 2; ++n) acc[a][b][m][n] = (f32x4){0.f, 0.f, 0.f, 0.f};
    bf16x8 At[4][2], B0[2][2], B1[2][2];
    const char* cA = (const char*)g.A + (size_t)cur.pm * tstepA; const char* cB = (const char*)g.Bt + (size_t)cur.pn * tstepB;
    PG8_STAGE(PG8_SB(0, 0), cB, voffB); PG8_STAGE(PG8_SB(0, 1), cB + hstepB, voffB); PG8_STAGE(PG8_SA(0, 0), cA, voffA); PG8_STAGE(PG8_SA(0, 1), cA + hstepA, voffA);
    if (wr == 1) PG8_BAR;
    PG8_WAIT_V(2); PG8_BAR;
    PG8_STAGE(PG8_SB(1, 0), cB + kstep, voffB); PG8_STAGE(PG8_SA(1, 0), cA + kstep, voffA); PG8_STAGE(PG8_SB(1, 1), cB + hstepB + kstep, voffB);
    PG8_WAIT_V(6); PG8_BAR;
    for (;;) {
        const bool has_next = S.next(ui + 1, nxt);
        const char* nA = has_next ? (const char*)g.A + (size_t)nxt.pm * tstepA : cA; const char* nB = has_next ? (const char*)g.Bt + (size_t)nxt.pn * tstepB : cB;
#pragma unroll 1
        for (int t = 0; t < nt; t += 2) {
            const bool last = (t == nt - 2);
            const char* a1 = cA + (size_t)(t + 1) * kstep;
            const char* a2 = last ? nA : cA + (size_t)(t + 2) * kstep; const char* b2 = last ? nB : cB + (size_t)(t + 2) * kstep;
            const char* a3 = a2 + kstep; const char* b3 = b2 + kstep;
            PG8_LDB(B0, 0, 0); PG8_LDB(B1, 0, 1); PG8_SCHED; PG8_LDA(At, 0, 0); PG8_STAGE(PG8_SA(1, 1), a1 + hstepA, voffA);
            PG8_WAIT_V(8); PG8_WAIT_L(0); PG8_BAR; PG8_MMA(0, 0, At, B0); PG8_MMA(0, 1, At, B1); PG8_BAR; PG8_SCHED;
            PG8_LDA(At, 0, 1); PG8_STAGE(PG8_SB(0, 0), b2, voffB); PG8_STAGE(PG8_SB(0, 1), b2 + hstepB, voffB); PG8_STAGE(PG8_SA(0, 0), a2, voffA);
            PG8_WAIT_V(8); PG8_WAIT_L(0); PG8_BAR; PG8_MMA(1, 0, At, B0); PG8_MMA(1, 1, At, B1); PG8_BAR; PG8_SCHED;
            PG8_LDB(B0, 1, 0); PG8_LDB(B1, 1, 1); PG8_SCHED; PG8_LDA(At, 1, 0); PG8_STAGE(PG8_SA(0, 1), a2 + hstepA, voffA);
            PG8_WAIT_V(8); PG8_WAIT_L(0); PG8_BAR; PG8_MMA(0, 0, At, B0); PG8_MMA(0, 1, At, B1); PG8_BAR; PG8_SCHED;
            PG8_LDA(At, 1, 1); PG8_STAGE(PG8_SB(1, 0), b3, voffB); PG8_STAGE(PG8_SB(1, 1), b3 + hstepB, voffB); PG8_STAGE(PG8_SA(1, 0), a3, voffA);
            PG8_WAIT_V(8); PG8_WAIT_L(0); PG8_BAR; PG8_MMA(1, 0, At, B0); PG8_MMA(1, 1, At, B1); PG8_BAR; PG8_SCHED;
        }
        if constexpr (ALIGN_EPI) { if (wr == 0) PG8_BAR; }
        E(acc, cur, wr, wc, fr, fq);
        if (!has_next) break;
#pragma unroll
        for (int a = 0; a < 2; ++a)
#pragma unroll
            for (int b = 0; b < 2; ++b)
#pragma unroll
                for (int m = 0; m < 4; ++m)
#pragma unroll
                    for (int n = 0; n < 2; ++n) acc[a][b][m][n] = (f32x4){0.f, 0.f, 0.f, 0.f};
        cur = nxt; cA = nA; cB = nB; ++ui;
        if constexpr (ALIGN_EPI) { if (wr == 1) PG8_BAR; }
    }
    PG8_WAIT_V(0);
    if constexpr (!ALIGN_EPI) { if (wr == 0) PG8_BAR; }
    PG8_BAR;
#undef PG8_SA
#undef PG8_SB
#undef PG8_STAGE
#undef PG8_LDA
#undef PG8_LDB
#undef PG8_MMA
#undef PG8_WAIT_V
#undef PG8_WAIT_L
#undef PG8_BAR
#undef PG8_SCHED
}
}


typedef unsigned long long u64_t;
__device__ __forceinline__ void wt16b(const void* base, void* p, pg8::u32x4 v) {
    const __amdgpu_buffer_rsrc_t r = __builtin_amdgcn_make_buffer_rsrc((void*)base, 0, 0x7fffffff, 0x00020000);
    __builtin_amdgcn_raw_buffer_store_b128(v, r, (unsigned)((const char*)p - (const char*)base), 0, 16);
}
#define wt16(p, v) wt16b(WSB, (p), (v))
#define wt16f(p, v) wt16b(WSB, (p), __builtin_bit_cast(pg8::u32x4, (v)))
#define wt16f_base(b, p, v) wt16b((b), (p), __builtin_bit_cast(pg8::u32x4, (v)))
__device__ __forceinline__ void wt8(void* p, unsigned lo, unsigned hi) { __hip_atomic_store((u64_t*)p, (u64_t)lo | ((u64_t)hi << 32), __ATOMIC_RELAXED, __HIP_MEMORY_SCOPE_AGENT); }
__device__ __forceinline__ void wt4f(float* p, float v) { __hip_atomic_store(p, v, __ATOMIC_RELAXED, __HIP_MEMORY_SCOPE_AGENT); }
using pg8::bf16_t; using pg8::f32x4; using pg8::u32x4; using pg8::bf16x8; using pg8::cvt_pk_bf16;
typedef float f32x16 __attribute__((ext_vector_type(16)));
typedef unsigned u32x2 __attribute__((ext_vector_type(2)));
#define LAS __attribute__((address_space(3)))

constexpr int NB = 8, SEQ = 2048, T = NB * SEQ, DM = 1024, FF = 2816, DEPTH = 4;
constexpr int XLD = 2048;
constexpr int HLD = 4096;
constexpr int NU = 4608;
constexpr int DIN = 4544;
constexpr int UZ = 0, UX = 1024, UB = 2048, UC = 2304, UQ = 2560, UKV = 2816, UPE = 2944, UDT = 2976, UCH = 3072, UCB = 3584, UCC = 4096;
constexpr float EPS = 1e-6f;
constexpr int NWAVES = 8, NTHR = 512;
constexpr int LDS_BYTES = 147456;

constexpr size_t MiB = 1u << 20;
constexpr size_t WS_CTL = 0;
constexpr size_t CTL_ROWSS = 0;
constexpr size_t CTL_QSS = (size_t)T * 16 * 4;
constexpr size_t CTL_KVSS = CTL_QSS + (size_t)T * 4 * 4;
constexpr size_t CTL_END = CTL_KVSS + (size_t)T * 4 * 4;
constexpr size_t WS_BAR = WS_CTL + 1536 * 1024;
static_assert(CTL_END <= WS_BAR, "ctl map");
constexpr size_t WS_CS = 2 * MiB;
constexpr size_t WS_DT = 4 * MiB;
constexpr size_t WS_W = 6 * MiB;
constexpr size_t W_GU1 = 0, W_D1 = W_GU1 + (size_t)5632 * 1024 * 2, W_IN = W_D1 + (size_t)1024 * HLD * 2, W_UQ = W_IN + (size_t)NU * 1024 * 2,
                 W_UKV = W_UQ + (size_t)768 * 256 * 2, W_OUT = W_UKV + (size_t)1024 * 128 * 2, W_GU2 = W_OUT + (size_t)1024 * 2048 * 2, W_D2 = W_GU2 + (size_t)5632 * 1024 * 2,
                 W_END = W_D2 + (size_t)1024 * HLD * 2;
constexpr size_t WS_U = WS_W + ((W_END + MiB - 1) / MiB) * MiB;
constexpr size_t WS_XB = WS_U + (size_t)T * NU * 2;
constexpr size_t WS_Y = WS_XB + (size_t)T * XLD * 2;
constexpr size_t WS_QR = WS_Y + (size_t)T * 2048 * 2;
constexpr size_t WS_KF = WS_QR + (size_t)T * 768 * 2;
constexpr size_t WS_VT = WS_KF + (size_t)T * 768 * 2;
constexpr size_t WS_YF = WS_VT + (size_t)T * 512 * 2;
constexpr size_t WS_END = WS_YF + (size_t)T * 1024 * 2;
static_assert(WS_END <= 457509120ull && (size_t)T * HLD * 2 <= (size_t)T * NU * 2, "workspace map must fit sum(inputs) bytes; H overlays U");

struct Args {
    const float* x; const int* pos;
    const float *ffn1_norm, *ffn1_wg, *ffn1_wu, *ffn1_wd, *mix_norm, *w_in, *ssd_conv_w, *ssd_conv_b, *ssd_dt_bias, *ssd_a_log, *ssd_d, *ssd_norm,
                *mla_q_norm, *mla_w_uq, *mla_kv_norm, *mla_w_ukv, *mla_qhn, *mla_khn, *mla_out_norm, *conv_w, *conv_out_norm, *w_out,
                *ffn2_norm, *ffn2_wg, *ffn2_wu, *ffn2_wd;
    float* out; unsigned char* ws;
    int ph_lo, ph_hi;
};

typedef const __attribute__((address_space(4))) Args* CArgs;
__device__ __forceinline__ CArgs get_args() { CArgs p = (CArgs)__builtin_amdgcn_kernarg_segment_ptr(); asm volatile("" : "+s"(p)); return p; }
__device__ __forceinline__ float bf2f(unsigned short h) { return __uint_as_float((unsigned)h << 16); }
__device__ __forceinline__ void unpack8(const u32x4 v, float (&f)[8]) {
#pragma unroll
    for (int i = 0; i < 4; ++i) { f[2 * i] = __uint_as_float(v[i] << 16); f[2 * i + 1] = __uint_as_float(v[i] & 0xffff0000u); }
}
__device__ __forceinline__ u32x4 pack8(const float (&f)[8]) { u32x4 v; v.x = cvt_pk_bf16(f[0], f[1]); v.y = cvt_pk_bf16(f[2], f[3]); v.z = cvt_pk_bf16(f[4], f[5]); v.w = cvt_pk_bf16(f[6], f[7]); return v; }
__device__ __forceinline__ unsigned short f2bf(float f) { return (unsigned short)(cvt_pk_bf16(f, 0.f) & 0xffffu); }
__device__ __forceinline__ float silu_f(float x) { return x * __builtin_amdgcn_rcpf(1.f + __expf(-x)); }
__device__ __forceinline__ float softplus_f(float x) { return fmaxf(x, 0.f) + log1pf(__expf(-fabsf(x))); }

__device__ __forceinline__ float sum16(const float* p) {
    const f32x4 a = *(const f32x4*)p, b = *(const f32x4*)(p + 4), c = *(const f32x4*)(p + 8), d = *(const f32x4*)(p + 12);
    return (((a[0] + a[1]) + (a[2] + a[3])) + ((b[0] + b[1]) + (b[2] + b[3]))) + (((c[0] + c[1]) + (c[2] + c[3])) + ((d[0] + d[1]) + (d[2] + d[3])));
}
__device__ __forceinline__ float sum4q(const f32x4 a) { return (a[0] + a[1]) + (a[2] + a[3]); }
__device__ __forceinline__ float sum4(const float* p) { const f32x4 a = *(const f32x4*)p; return (a[0] + a[1]) + (a[2] + a[3]); }
struct EpiSwiglu {
    const unsigned char* WSB;
    bf16_t* H; const float* rowss;
    __device__ __forceinline__ void operator()(const f32x4 (&acc)[2][2][4][2], const pg8::Unit& u, int wr, int wc, int fr, int fq) const {
        const int row0 = u.pm * 256 + wr * 64 + fr, col0 = u.pn * 128 + wc * 32 + 8 * fq;
        f32x4 rq[2][4];
#pragma unroll
        for (int ai = 0; ai < 2; ++ai)
#pragma unroll
            for (int m = 0; m < 4; ++m) rq[ai][m] = *(const f32x4*)(rowss + (size_t)(row0 + ai * 128 + m * 16) * 16 + 4 * fq);
#pragma unroll
        for (int ai = 0; ai < 2; ++ai)
#pragma unroll
            for (int m = 0; m < 4; ++m) {
                const int row = row0 + ai * 128 + m * 16;
                float ssq = sum4q(rq[ai][m]); ssq += __shfl_xor(ssq, 16); ssq += __shfl_xor(ssq, 32);
                const float r = rsqrtf(ssq * (1.f / DM) + EPS);
                float h[8];
#pragma unroll
                for (int n = 0; n < 2; ++n)
#pragma unroll
                    for (int i = 0; i < 4; ++i) h[4 * n + i] = silu_f(acc[ai][0][m][n][i] * r) * (acc[ai][1][m][n][i] * r);
                wt16(H + (size_t)row * HLD + col0, pack8(h));
            }
    }
};
struct EpiResid {
    const unsigned char* WSB;
    const float* base; float* out; bf16_t* xb; float* ss; float scale;
    __device__ __forceinline__ void operator()(const f32x4 (&acc)[2][2][4][2], const pg8::Unit& u, int wr, int wc, int fr, int fq) const {
        const int row0 = u.pm * 256 + wr * 64 + fr, col0 = u.pn * 256 + wc * 32 + 8 * fq;
        f32x4 pre[4][2][2];
#pragma unroll
        for (int m = 0; m < 4; ++m)
#pragma unroll
            for (int bj = 0; bj < 2; ++bj) { const size_t off = (size_t)(row0 + m * 16) * DM + col0 + bj * 128;
                pre[m][bj][0] = *(const f32x4*)(base + off); pre[m][bj][1] = *(const f32x4*)(base + off + 4); }
#pragma unroll
        for (int ai = 0; ai < 2; ++ai)
#pragma unroll
            for (int m = 0; m < 4; ++m) {
                const int row = row0 + ai * 128 + m * 16; float part = 0.f;
                f32x4 v[2][2];
#pragma unroll
                for (int bj = 0; bj < 2; ++bj) { v[bj][0] = pre[m][bj][0] + acc[ai][bj][m][0] * scale; v[bj][1] = pre[m][bj][1] + acc[ai][bj][m][1] * scale; }
                if (ai == 0) {
#pragma unroll
                    for (int bj = 0; bj < 2; ++bj) { const size_t off2 = (size_t)(row + 128) * DM + col0 + bj * 128;
                        pre[m][bj][0] = *(const f32x4*)(base + off2); pre[m][bj][1] = *(const f32x4*)(base + off2 + 4); }
                }
#pragma unroll
                for (int bj = 0; bj < 2; ++bj) {
                    const size_t off = (size_t)row * DM + col0 + bj * 128;
                    const f32x4 v0 = v[bj][0], v1 = v[bj][1];
                    *(f32x4*)(out + off) = v0; *(f32x4*)(out + off + 4) = v1;
                    u32x4 w; w.x = cvt_pk_bf16(v0[0], v0[1]); w.y = cvt_pk_bf16(v0[2], v0[3]); w.z = cvt_pk_bf16(v1[0], v1[1]); w.w = cvt_pk_bf16(v1[2], v1[3]);
                    wt16(xb + (size_t)row * XLD + col0 + bj * 128, w);
                    part += (v0[0] * v0[0] + v0[1] * v0[1]) + (v0[2] * v0[2] + v0[3] * v0[3]) + (v1[0] * v1[0] + v1[1] * v1[1]) + (v1[2] * v1[2] + v1[3] * v1[3]);
                }
                part += __shfl_xor(part, 16); part += __shfl_xor(part, 32);
                if (fq == 0) wt4f(ss + (size_t)row * 16 + u.pn * 4 + wc, part);
            }
    }
};
struct EpiU {
    const unsigned char* WSB;
    bf16_t* U; const float* rowss; float* qss; float* kvss; float* DT; const float* dt_bias;
    __device__ __forceinline__ void operator()(const f32x4 (&acc)[2][2][4][2], const pg8::Unit& u, int wr, int wc, int fr, int fq) const {
        const int row0 = u.pm * 256 + wr * 64 + fr, col0 = u.pn * 256 + wc * 32 + 8 * fq; const int pn = u.pn;
        f32x4 rq[2][4];
#pragma unroll
        for (int ai = 0; ai < 2; ++ai)
#pragma unroll
            for (int m = 0; m < 4; ++m) rq[ai][m] = *(const f32x4*)(rowss + (size_t)(row0 + ai * 128 + m * 16) * 16 + 4 * fq);
#pragma unroll
        for (int ai = 0; ai < 2; ++ai)
#pragma unroll
            for (int m = 0; m < 4; ++m) {
                const int row = row0 + ai * 128 + m * 16;
                float ssq = sum4q(rq[ai][m]); ssq += __shfl_xor(ssq, 16); ssq += __shfl_xor(ssq, 32);
                const float r = rsqrtf(ssq * (1.f / DM) + EPS);
                float sq = 0.f;
#pragma unroll
                for (int bj = 0; bj < 2; ++bj) {
                    float v[8];
#pragma unroll
                    for (int n = 0; n < 2; ++n)
#pragma unroll
                        for (int i = 0; i < 4; ++i) v[4 * n + i] = acc[ai][bj][m][n][i] * r;
                    if (pn == 11 && bj == 1 && wc == 1) {
                        float d[8];
#pragma unroll
                        for (int e = 0; e < 8; ++e) d[e] = softplus_f(v[e] + dt_bias[8 * fq + e]);
                        { const f32x4 dlo = {d[0], d[1], d[2], d[3]}; wt16f(DT + (size_t)row * 32 + 8 * fq, dlo); }
                        { const f32x4 dhi = {d[4], d[5], d[6], d[7]}; wt16f(DT + (size_t)row * 32 + 8 * fq + 4, dhi); }
                    } else {
                        wt16(U + (size_t)row * NU + col0 + bj * 128, pack8(v));
                    }
                    if (pn == 10 || (pn == 11 && bj == 0)) {
#pragma unroll
                        for (int e = 0; e < 8; ++e) sq += v[e] * v[e];
                    }
                }
                if (pn == 10 || pn == 11) {
                    sq += __shfl_xor(sq, 16); sq += __shfl_xor(sq, 32);
                    if (fq == 0) wt4f((pn == 10 ? qss : kvss) + (size_t)row * 4 + wc, sq);
                }
            }
    }
};
struct EpiQ {
    const unsigned char* WSB;
    bf16_t* O; const float* qss;
    __device__ __forceinline__ void operator()(const f32x4 (&acc)[2][2][4][2], const pg8::Unit& u, int wr, int wc, int fr, int fq) const {
        const int row0 = u.pm * 256 + wr * 64 + fr, col0 = u.pn * 256 + wc * 32 + 8 * fq;
        f32x4 rq[2][4];
#pragma unroll
        for (int ai = 0; ai < 2; ++ai)
#pragma unroll
            for (int m = 0; m < 4; ++m) rq[ai][m] = *(const f32x4*)(qss + (size_t)(row0 + ai * 128 + m * 16) * 4);
#pragma unroll
        for (int ai = 0; ai < 2; ++ai)
#pragma unroll
            for (int m = 0; m < 4; ++m) {
                const int row = row0 + ai * 128 + m * 16; const float r = rsqrtf(sum4q(rq[ai][m]) * (1.f / 256.f) + EPS);
#pragma unroll
                for (int bj = 0; bj < 2; ++bj) {
                    float v[8];
#pragma unroll
                    for (int n = 0; n < 2; ++n)
#pragma unroll
                        for (int i = 0; i < 4; ++i) v[4 * n + i] = acc[ai][bj][m][n][i] * r;
                    wt16(O + (size_t)row * 768 + col0 + bj * 128, pack8(v));
                }
            }
    }
};
struct EpiKV {
    const unsigned char* WSB;
    const bf16_t* U; const float* kvss; const float* khn; const float2* cs; bf16_t* Kf; bf16_t* Vt;
    __device__ __forceinline__ void operator()(const f32x4 (&acc)[2][2][4][2], const pg8::Unit& u, int wr, int wc, int fr, int fq) const {
        const int row0 = u.pm * 256 + wr * 64 + fr; const int pn = u.pn;
        f32x4 rq[2][4];
#pragma unroll
        for (int ai = 0; ai < 2; ++ai)
#pragma unroll
            for (int m = 0; m < 4; ++m) { const int rw = row0 + ai * 128 + m * 16; rq[ai][m] = *(const f32x4*)(kvss + (size_t)rw * 4); }
#pragma unroll
        for (int ai = 0; ai < 2; ++ai)
#pragma unroll
            for (int m = 0; m < 4; ++m) {
                const int row = row0 + ai * 128 + m * 16; const float rkv = rsqrtf(sum4q(rq[ai][m]) * (1.f / 128.f) + EPS);
                const int b = row >> 11, s = row & (SEQ - 1);
                float v[2][8];
#pragma unroll
                for (int bj = 0; bj < 2; ++bj)
#pragma unroll
                    for (int n = 0; n < 2; ++n)
#pragma unroll
                        for (int i = 0; i < 4; ++i) v[bj][4 * n + i] = acc[ai][bj][m][n][i] * rkv;
                if (pn < 2) {
                    const int head = 4 * pn + wc;
                    float ssn = 0.f;
#pragma unroll
                    for (int bj = 0; bj < 2; ++bj)
#pragma unroll
                        for (int e = 0; e < 8; ++e) ssn += v[bj][e] * v[bj][e];
                    float pe[8]; unpack8(*(const u32x4*)(U + (size_t)row * NU + UPE + 8 * fq), pe);
#pragma unroll
                    for (int e = 0; e < 8; ++e) ssn += pe[e] * pe[e];
                    ssn += __shfl_xor(ssn, 16); ssn += __shfl_xor(ssn, 32);
                    const float rk = rsqrtf(ssn * (1.f / 96.f) + EPS);
                    bf16_t* kb = Kf + ((size_t)(b * 8 + head) * SEQ + s) * 96;
#pragma unroll
                    for (int bj = 0; bj < 2; ++bj) {
                        float o[8];
#pragma unroll
                        for (int e = 0; e < 8; ++e) o[e] = v[bj][e] * rk * khn[32 * bj + 8 * fq + e];
                        wt16(kb + 32 * bj + 8 * fq, pack8(o));
                    }
                    float o[8];
#pragma unroll
                    for (int e = 0; e < 8; ++e) {
                        const float mine = pe[e] * rk * khn[64 + 8 * fq + e];
                        const float other = __shfl_xor(mine, 32);
                        const float2 c = cs[(size_t)row * 16 + ((8 * fq + e) & 15)];
                        o[e] = (fq < 2) ? (mine * c.x - other * c.y) : (other * c.y + mine * c.x);
                    }
                    wt16(kb + 64 + 8 * fq, pack8(o));
                } else {
                    const int head = 4 * (pn - 2) + wc;
                    bf16_t* vb = Vt + ((size_t)(b * 8 + head) * SEQ + s) * 64;
#pragma unroll
                    for (int bj = 0; bj < 2; ++bj) wt16(vb + 32 * bj + 8 * fq, pack8(v[bj]));
                }
            }
    }
};

struct CvtDesc { const float* W; const float* gain; bf16_t* WT; int N, K, srccol, destrow, k0, ld; };
__device__ __forceinline__ void cvt_load(const CvtDesc& d, float (&wv)[32], int lane) {
    if (d.W) {
#pragma unroll
        for (int i = 0; i < 32; ++i) { const int kk = 2 * i + (lane >> 5); wv[i] = __builtin_nontemporal_load(d.W + (size_t)(d.k0 + kk) * d.N + d.srccol + (lane & 31)); }
    } else {
#pragma unroll
        for (int i = 0; i < 32; ++i) wv[i] = 0.f;
    }
}
__device__ __forceinline__ void cvt_store(const unsigned char* WSB, const CvtDesc& d, const float (&wv)[32], LAS float* scr, int lane) {
#pragma unroll
    for (int i = 0; i < 32; ++i) scr[(2 * i + (lane >> 5)) * 33 + (lane & 31)] = wv[i];
    const int c = lane & 7;
    float g[8];
    if (d.gain) { const f32x4 g0 = *(const f32x4*)(d.gain + d.k0 + 8 * c), g1 = *(const f32x4*)(d.gain + d.k0 + 8 * c + 4);
        g[0] = g0[0]; g[1] = g0[1]; g[2] = g0[2]; g[3] = g0[3]; g[4] = g1[0]; g[5] = g1[1]; g[6] = g1[2]; g[7] = g1[3]; }
    else {
#pragma unroll
        for (int e = 0; e < 8; ++e) g[e] = 1.f;
    }
    asm volatile("s_waitcnt lgkmcnt(0)" ::: "memory");
#pragma unroll
    for (int j = 0; j < 4; ++j) { const int n = (lane >> 3) + 8 * j; const LAS float* sp = scr + (8 * c) * 33 + n;
        u32x4 o; o.x = cvt_pk_bf16(sp[0 * 33] * g[0], sp[1 * 33] * g[1]); o.y = cvt_pk_bf16(sp[2 * 33] * g[2], sp[3 * 33] * g[3]);
        o.z = cvt_pk_bf16(sp[4 * 33] * g[4], sp[5 * 33] * g[5]); o.w = cvt_pk_bf16(sp[6 * 33] * g[6], sp[7 * 33] * g[7]);
        wt16(d.WT + (size_t)(d.destrow + n) * d.ld + d.k0 + 8 * c, o); }
    asm volatile("s_waitcnt lgkmcnt(0)" ::: "memory");
}

__device__ __forceinline__ float wave_sum(float v) {
#pragma unroll
    for (int o = 1; o < 64; o <<= 1) v += __shfl_xor(v, o);
    return v;
}

__device__ __forceinline__ CvtDesc cvt_decode(CArgs a, int layer, int it) {
    unsigned char* wsw = a->ws + WS_W;
    constexpr int I_GU = 16 * 176, I_D = 44 * 32, I_IN = 16 * 144, I_UQ = 4 * 24, I_UKV = 2 * 32;
    CvtDesc d;
    int r = it;
    if (r < 2 * I_GU) {
        const int which = r / I_GU; r -= which * I_GU;
        const int db = r % 176, kb = r / 176, tile = db >> 3, sub = db & 7;
        const float* Wg = (which ? a->ffn2_wg : a->ffn1_wg) + (size_t)layer * DM * FF; const float* Wu = (which ? a->ffn2_wu : a->ffn1_wu) + (size_t)layer * DM * FF;
        d.W = sub < 4 ? Wg : Wu; d.gain = (which ? a->ffn2_norm : a->ffn1_norm) + layer * DM; d.WT = (bf16_t*)(wsw + (which ? W_GU2 : W_GU1));
        d.N = FF; d.K = DM; d.ld = DM; d.srccol = tile * 128 + (sub & 3) * 32; d.destrow = db * 32; d.k0 = kb * 64; return d;
    }
    r -= 2 * I_GU;
    if (r < 2 * I_D) {
        const int which = r / I_D; r -= which * I_D;
        const int db = r % 32, kb = r / 32;
        d.W = (which ? a->ffn2_wd : a->ffn1_wd) + (size_t)layer * FF * DM; d.gain = nullptr; d.WT = (bf16_t*)(wsw + (which ? W_D2 : W_D1));
        d.N = DM; d.K = FF; d.ld = HLD; d.srccol = db * 32; d.destrow = db * 32; d.k0 = kb * 64; return d;
    }
    r -= 2 * I_D;
    if (r < I_IN) {
        const int db = r % 144, kb = r / 144, uc = db * 32;
        int oc;
        if (uc < 2560) oc = uc; else if (uc < 2816) oc = 2592 + (uc - 2560); else if (uc < 2944) oc = 2848 + (uc - 2816); else if (uc < 2976) oc = 2976 + (uc - 2944);
        else if (uc < 3008) oc = 2560 + (uc - 2976); else if (uc < 3072) oc = -1; else oc = 3008 + (uc - 3072);
        d.W = oc >= 0 ? a->w_in + (size_t)layer * DM * DIN : nullptr; d.gain = a->mix_norm + layer * DM; d.WT = (bf16_t*)(wsw + W_IN);
        d.N = DIN; d.K = DM; d.ld = DM; d.srccol = oc; d.destrow = uc; d.k0 = kb * 64; return d;
    }
    r -= I_IN;
    if (r < I_UQ) {
        const int db = r % 24, kb = r / 24;
        d.W = a->mla_w_uq + (size_t)layer * 256 * 768; d.gain = a->mla_q_norm + layer * 256; d.WT = (bf16_t*)(wsw + W_UQ);
        d.N = 768; d.K = 256; d.ld = 256; d.srccol = db * 32; d.destrow = db * 32; d.k0 = kb * 64; return d;
    }
    r -= I_UQ;
    if (r < I_UKV) {
        const int db = r % 32, kb = r / 32, pn = db >> 3, bj = (db & 7) >> 2, wc = db & 3;
        d.W = a->mla_w_ukv + (size_t)layer * 128 * 1024; d.gain = a->mla_kv_norm + layer * 128; d.WT = (bf16_t*)(wsw + W_UKV);
        d.N = 1024; d.K = 128; d.ld = 128; d.srccol = (pn < 2) ? (4 * pn + wc) * 128 + 32 * bj : (4 * (pn - 2) + wc) * 128 + 64 + 32 * bj; d.destrow = db * 32; d.k0 = kb * 64; return d;
    }
    r -= I_UKV;
    {
        const int db = r % 32, kb = r / 32, k0 = kb * 64;
        d.W = a->w_out + (size_t)layer * 2048 * DM;
        d.gain = (k0 < 1024) ? a->ssd_norm + layer * 1024 : (k0 < 1536) ? a->mla_out_norm + layer * 512 - 1024 : a->conv_out_norm + layer * 512 - 1536;
        d.WT = (bf16_t*)(wsw + W_OUT); d.N = DM; d.K = 2048; d.ld = 2048; d.srccol = db * 32; d.destrow = db * 32; d.k0 = k0; return d;
    }
}

__device__ __forceinline__ void phase_convert(CArgs a, int layer, LAS unsigned char* lds, int G) {
    const unsigned char* WSB = a->ws;
    const int tid = ltid(), lane = tid & 63, wave = tid >> 6;
    LAS float* scr = (LAS float*)(lds + wave * 16384);
    const int gw = lbid() * NWAVES + wave, NGW = G * NWAVES;
    constexpr int NIT = 2 * 16 * 176 + 2 * 44 * 32 + 16 * 144 + 4 * 24 + 2 * 32 + 32 * 32;
    {
        int it = gw;
        float wv[32]; CvtDesc cur;
        if (it < NIT) { cur = cvt_decode(a, layer, it); cvt_load(cur, wv, lane); }
#pragma unroll 1
        while (it < NIT) {
            const int nxt = it + NGW;
            float wn[32]; CvtDesc nd = cur;
            if (nxt < NIT) { nd = cvt_decode(a, layer, nxt); cvt_load(nd, wn, lane); }
            cvt_store(WSB, cur, wv, scr, lane);
#pragma unroll
            for (int i = 0; i < 32; ++i) wv[i] = wn[i];
            cur = nd; it = nxt;
        }
    }
    if (layer == 0) {
        float* ctl = (float*)(a->ws + WS_CTL + CTL_ROWSS);
        bf16_t* xb = (bf16_t*)(a->ws + WS_XB);
        for (int m = gw; m < T; m += NGW) {
            const f32x4* xr = (const f32x4*)(a->x + (size_t)m * DM) + lane; float s = 0.f;
#pragma unroll
            for (int j = 0; j < 4; ++j) { const f32x4 v = xr[64 * j]; s += (v[0] * v[0] + v[1] * v[1]) + (v[2] * v[2] + v[3] * v[3]);
                u32x2 w; w.x = cvt_pk_bf16(v[0], v[1]); w.y = cvt_pk_bf16(v[2], v[3]); wt8(xb + (size_t)m * XLD + 256 * j + 4 * lane, w.x, w.y); }
            s = wave_sum(s);
            if (lane < 16) wt4f(ctl + (size_t)m * 16 + lane, (lane == 0) ? s : 0.f);
        }
        float2* cst = (float2*)(a->ws + WS_CS);
        for (int i = lbid() * NTHR + tid; i < T * 16; i += G * NTHR) {
            const int tok = i >> 4, j = i & 15;
            const float inv = powf(10000.f, -(float)j / 16.f);
            const float ang = (float)a->pos[tok] * inv;
            const double rev = (double)ang * 0.15915494309189535; const double fr = rev - rint(rev);
            wt8(cst + i, __float_as_uint(__builtin_amdgcn_cosf((float)fr)), __float_as_uint(__builtin_amdgcn_sinf((float)fr)));
        }
    }
}

constexpr int YS_LD = 72;
constexpr int SS_LD = 136;
constexpr int SS_CM = 0, SS_BW = 34816, SS_BT = 69632, SS_XT = 104448, SS_SB = 121856, SS_VEC = 139264;

template <int R>
__device__ __forceinline__ void conv_rows(const bf16_t* Ub, int s0, int c0, const float* cw, const float* cb, float (&out)[R][8]) {
    float w[5][8], bias[8];
#pragma unroll
    for (int k = 0; k < 5; ++k) { const f32x4 a0 = *(const f32x4*)(cw + k * 1536 + c0), a1 = *(const f32x4*)(cw + k * 1536 + c0 + 4);
        w[k][0] = a0[0]; w[k][1] = a0[1]; w[k][2] = a0[2]; w[k][3] = a0[3]; w[k][4] = a1[0]; w[k][5] = a1[1]; w[k][6] = a1[2]; w[k][7] = a1[3]; }
    { const f32x4 a0 = *(const f32x4*)(cb + c0), a1 = *(const f32x4*)(cb + c0 + 4);
      bias[0] = a0[0]; bias[1] = a0[1]; bias[2] = a0[2]; bias[3] = a0[3]; bias[4] = a1[0]; bias[5] = a1[1]; bias[6] = a1[2]; bias[7] = a1[3]; }
#pragma unroll
    for (int r = 0; r < R; ++r)
#pragma unroll
        for (int e = 0; e < 8; ++e) out[r][e] = bias[e];
#pragma unroll
    for (int i = 0; i < R + 4; ++i) {
        const int sp = s0 - 2 + i;
        float in[8];
        const int spc = sp < 0 ? 0 : (sp > SEQ - 1 ? SEQ - 1 : sp);
        u32x4 raw = *(const u32x4*)(Ub + (size_t)spc * NU + UX + c0);
        if (sp != spc) raw = (u32x4){0u, 0u, 0u, 0u};
        unpack8(raw, in);
#pragma unroll
        for (int r = 0; r < R; ++r) { const int k = i - r; if (k >= 0 && k < 5) {
#pragma unroll
            for (int e = 0; e < 8; ++e) out[r][e] += w[k][e] * in[e]; } }
    }
#pragma unroll
    for (int r = 0; r < R; ++r)
#pragma unroll
        for (int e = 0; e < 8; ++e) out[r][e] = silu_f(out[r][e]);
}

typedef short v4i16_t __attribute__((ext_vector_type(4)));
#define MFMA32(a, b, c) __builtin_amdgcn_mfma_f32_32x32x16_bf16((a), (b), (c), 0, 0, 0)
__device__ __forceinline__ int crow(int r, int hi) { return (r & 3) + 8 * (r >> 2) + 4 * hi; }


__device__ __forceinline__ void ssd_bc_slice(CArgs a, int layer, int item) {
    const unsigned char* WSB = a->ws;
    const int tid = ltid(), cgp = tid & 63, rb = tid >> 6, b = item >> 5, sl = item & 31;
    const bf16_t* Ub = (const bf16_t*)(a->ws + WS_U) + (size_t)b * SEQ * NU;
    bf16_t* XA = (bf16_t*)(a->ws + WS_XB) + (size_t)b * SEQ * 512;
    const float* cw = a->ssd_conv_w + (size_t)layer * 5 * 1536; const float* cb = a->ssd_conv_b + (size_t)layer * 1536;
    float o[8][8];
    const int s0 = sl * 64 + rb * 8;
    conv_rows<8>(Ub, s0, 1024 + cgp * 8, cw, cb, o);
#pragma unroll
    for (int r = 0; r < 8; ++r) wt16(XA + (size_t)(s0 + r) * 512 + cgp * 8, pack8(o[r]));
}
__device__ __forceinline__ void sub_arrive(unsigned* cnt) {
    asm volatile("s_waitcnt vmcnt(0)" ::: "memory");
    __syncthreads();
    if (threadIdx.x == 0) (void)__hip_atomic_fetch_add(cnt, 1u, __ATOMIC_RELAXED, __HIP_MEMORY_SCOPE_AGENT);
}
__device__ __forceinline__ void sub_wait(unsigned* cnt, unsigned want) {
    if (threadIdx.x == 0) {
        unsigned sp = 0;
        while (__hip_atomic_load(cnt, __ATOMIC_RELAXED, __HIP_MEMORY_SCOPE_AGENT) < want) { __builtin_amdgcn_s_sleep(1); if (++sp > (1u << 22)) break; }
        __builtin_amdgcn_fence(__ATOMIC_ACQUIRE, "agent");
        asm volatile("s_waitcnt vmcnt(0)" ::: "memory");
    }
    __syncthreads();
}
__device__ __forceinline__ void ssd_item(CArgs a, int layer, int item, LAS unsigned char* lds) {
    const unsigned char* WSB = a->ws;
    const int tid0 = ltid();
    const int dir = item & 1, hd = (item >> 1) & 15, b = item >> 5, grp = hd >> 3;
    const bf16_t* Ub = (const bf16_t*)(a->ws + WS_U) + (size_t)b * SEQ * NU;
    const bf16_t* XA = (const bf16_t*)(a->ws + WS_XB) + (size_t)b * SEQ * 512;
    const float* DT = (const float*)(a->ws + WS_DT) + (size_t)b * SEQ * 32 + dir * 16 + hd;
    const int ystr = dir ? 1024 : 2048;
    bf16_t* yout = (dir ? (bf16_t*)(a->ws + WS_YF) : (bf16_t*)(a->ws + WS_Y)) + (size_t)b * SEQ * ystr + hd * 64;
    const float* cw = a->ssd_conv_w + (size_t)layer * 5 * 1536; const float* cb = a->ssd_conv_b + (size_t)layer * 1536;
    const float Aneg = -__expf(a->ssd_a_log[layer * 32 + dir * 16 + hd]) * 1.4426950408889634f;
    const float Dh = dir ? 0.f : a->ssd_d[layer * 16 + hd];
    LAS bf16_t* Cm = (LAS bf16_t*)(lds + SS_CM); LAS bf16_t* Bw = (LAS bf16_t*)(lds + SS_BW); LAS bf16_t* Bt = (LAS bf16_t*)(lds + SS_BT);
    LAS bf16_t* Xt = (LAS bf16_t*)(lds + SS_XT); LAS bf16_t* Sb = (LAS bf16_t*)(lds + SS_SB); LAS float* vec = (LAS float*)(lds + SS_VEC);
    LAS float* v_dA = vec, *v_cs = vec + 128, *v_ecs = vec + 256, *v_wgt = vec + 384, *v_dt = vec + 512;
    for (int i = tid0; i < 64 * SS_LD / 2; i += NTHR) ((LAS unsigned*)Sb)[i] = 0u;
    f32x16 Sacc; int tprev = 0;
#pragma unroll
    for (int r = 0; r < 16; ++r) Sacc[r] = 0.f;
    u32x4 pb[4], pc[4], px[6]; float pdt = 0.f;
#define SSD_PREFETCH(CC) do { const int tidp = ltid(); const int c_ = dir ? 15 - (CC) : (CC); const int t0_ = c_ * 128; \
        { const int cg8_ = tidp & 15, l0_ = (tidp >> 4) * 4; const bf16_t* xa_ = XA + (size_t)(t0_ + l0_) * 512 + grp * 128 + cg8_ * 8; \
          _Pragma("unroll") for (int r = 0; r < 4; ++r) { pb[r] = *(const u32x4*)(xa_ + (size_t)r * 512); pc[r] = *(const u32x4*)(xa_ + (size_t)r * 512 + 256); } } \
        { const int xg_ = tidp & 7, xl0_ = (tidp >> 3) * 2; \
          _Pragma("unroll") for (int i = 0; i < 6; ++i) { const int sp = t0_ + xl0_ - 2 + i; const int spc = sp < 0 ? 0 : (sp > SEQ - 1 ? SEQ - 1 : sp); \
              u32x4 raw = *(const u32x4*)(Ub + (size_t)spc * NU + UX + hd * 64 + xg_ * 8); if (sp != spc) raw = (u32x4){0u, 0u, 0u, 0u}; px[i] = raw; } } \
        pdt = (tidp < 128) ? DT[(size_t)(t0_ + tidp) * 32] : 0.f; } while (0)
    SSD_PREFETCH(0);
#pragma unroll 1
    for (int cc = 0; cc < 16; ++cc) {
        const int tid = ltid(), lane = tid & 63, wid = __builtin_amdgcn_readfirstlane(tid >> 6), r32 = lane & 31, hi = lane >> 5;
        const int yi = wid >> 1, yj = wid & 1;
        const int si = wid >> 2, sj = wid & 3;
        const int gi = wid >> 1, gj0 = (wid & 1) * 2;
        const int c = dir ? 15 - cc : cc; const int t0 = c * 128;
        const float dtv = pdt;
        if (tid < 128) v_dA[tid] = dtv * Aneg;
        __syncthreads();
        if (cc > 0) {
#pragma unroll
            for (int i = 0; i < 2; ++i) { const int c2 = tid + 512 * i, row = c2 >> 3, part = c2 & 7;
                wt16(yout + (size_t)(tprev + row) * ystr + part * 8, *(const LAS u32x4*)(Bw + row * YS_LD + part * 8)); }
        }
        float etot;
        {
            float tot = 0.f, pre = 0.f;
            if (tid < 128) {
                const float mine = v_dA[tid];
                float sc = mine;
#pragma unroll
                for (int o = 1; o < 64; o <<= 1) { const float tt = __shfl_up(sc, o); sc += (lane >= o) ? tt : 0.f; }
                const float w0 = wave_sum(v_dA[lane]), w1 = wave_sum(v_dA[64 + lane]);
                tot = w0 + w1; pre = sc + (wid == 1 ? w0 : 0.f);
                if (dir) pre = tot - pre + mine;
                v_cs[tid] = pre; v_ecs[tid] = __builtin_amdgcn_exp2f(pre); v_wgt[tid] = dtv * __builtin_amdgcn_exp2f(tot - pre); v_dt[tid] = dtv;
                if (tid == 0) vec[640] = __builtin_amdgcn_exp2f(tot);
            }
        }
        __syncthreads();
        etot = vec[640];
        {
            const int cg8 = tid & 15, rb = tid >> 4, l0 = rb * 4;
            float o[4][8];
            float wg[4];
#pragma unroll
            for (int r = 0; r < 4; ++r) { *(LAS u32x4*)(Cm + (l0 + r) * SS_LD + cg8 * 8) = pc[r]; *(LAS u32x4*)(Bw + (l0 + r) * SS_LD + cg8 * 8) = pb[r]; unpack8(pb[r], o[r]); wg[r] = v_wgt[l0 + r]; }
#pragma unroll
            for (int e = 0; e < 8; ++e) { u32x2 w; w.x = cvt_pk_bf16(o[0][e] * wg[0], o[1][e] * wg[1]); w.y = cvt_pk_bf16(o[2][e] * wg[2], o[3][e] * wg[3]);
                *(LAS u32x2*)(Bt + (cg8 * 8 + e) * SS_LD + l0) = w; }
            const int xg = tid & 7, xr = tid >> 3, xl0 = xr * 2;
            float ox[2][8];
            {
                const int c0 = hd * 64 + xg * 8;
                float bias[8];
                { const f32x4 a0 = *(const f32x4*)(cb + c0), a1 = *(const f32x4*)(cb + c0 + 4);
                  bias[0] = a0[0]; bias[1] = a0[1]; bias[2] = a0[2]; bias[3] = a0[3]; bias[4] = a1[0]; bias[5] = a1[1]; bias[6] = a1[2]; bias[7] = a1[3]; }
#pragma unroll
                for (int e = 0; e < 8; ++e) { ox[0][e] = bias[e]; ox[1][e] = bias[e]; }
#pragma unroll
                for (int k = 0; k < 5; ++k) {
                    const f32x4 a0 = *(const f32x4*)(cw + k * 1536 + c0), a1 = *(const f32x4*)(cw + k * 1536 + c0 + 4);
                    const float w[8] = {a0[0], a0[1], a0[2], a0[3], a1[0], a1[1], a1[2], a1[3]};
                    float i0[8], i1[8]; unpack8(px[k], i0); unpack8(px[k + 1], i1);
#pragma unroll
                    for (int e = 0; e < 8; ++e) { ox[0][e] += w[e] * i0[e]; ox[1][e] += w[e] * i1[e]; }
                }
#pragma unroll
                for (int e = 0; e < 8; ++e) { ox[0][e] = silu_f(ox[0][e]); ox[1][e] = silu_f(ox[1][e]); }
            }
#pragma unroll
            for (int e = 0; e < 8; ++e) *(LAS unsigned*)(Xt + (xg * 8 + e) * SS_LD + xl0) = cvt_pk_bf16(ox[0][e], ox[1][e]);
        }
        if (cc + 1 < 16) SSD_PREFETCH(cc + 1);
        __syncthreads();
        f32x16 G0, G1;
#pragma unroll
        for (int r = 0; r < 16; ++r) { G0[r] = 0.f; G1[r] = 0.f; }
#pragma unroll
        for (int ks = 0; ks < 8; ++ks) {
            const bf16x8 af = *(const LAS bf16x8*)(Cm + (32 * gi + r32) * SS_LD + 16 * ks + 8 * hi);
            const bf16x8 b0 = *(const LAS bf16x8*)(Bw + (32 * gj0 + r32) * SS_LD + 16 * ks + 8 * hi);
            const bf16x8 b1 = *(const LAS bf16x8*)(Bw + (32 * (gj0 + 1) + r32) * SS_LD + 16 * ks + 8 * hi);
            G0 = MFMA32(af, b0, G0); G1 = MFMA32(af, b1, G1);
        }
        __syncthreads();
        {
#pragma unroll
            for (int r = 0; r < 16; ++r) Sacc[r] *= etot;
#pragma unroll
            for (int ks = 0; ks < 8; ++ks) {
                const bf16x8 xa = *(const LAS bf16x8*)(Xt + (32 * si + r32) * SS_LD + 16 * ks + 8 * hi);
                const bf16x8 bb = *(const LAS bf16x8*)(Bt + (32 * sj + r32) * SS_LD + 16 * ks + 8 * hi);
                Sacc = MFMA32(xa, bb, Sacc);
            }
            const int s0i = 32 * gj0 + r32, s1i = s0i + 32;
            const float cs0 = v_cs[s0i], cs1 = v_cs[s1i], d0 = v_dt[s0i], d1 = v_dt[s1i];
#pragma unroll
            for (int r = 0; r < 16; ++r) {
                const int l = 32 * gi + crow(r, hi); const float csl = v_cs[l];
                const bool ok0 = dir ? (s0i >= l) : (s0i <= l), ok1 = dir ? (s1i >= l) : (s1i <= l);
                const float w0 = ok0 ? G0[r] * __builtin_amdgcn_exp2f(csl - cs0) * d0 : 0.f;
                const float w1 = ok1 ? G1[r] * __builtin_amdgcn_exp2f(csl - cs1) * d1 : 0.f;
                Bw[l * SS_LD + s0i] = f2bf(w0); Bw[l * SS_LD + s1i] = f2bf(w1);
            }
        }
        __syncthreads();
        float yv[16];
        {
            f32x16 Yd, Yo;
#pragma unroll
            for (int r = 0; r < 16; ++r) { Yd[r] = 0.f; Yo[r] = 0.f; }
#pragma unroll
            for (int ks = 0; ks < 8; ++ks) {
                const bf16x8 wa = *(const LAS bf16x8*)(Bw + (32 * yi + r32) * SS_LD + 16 * ks + 8 * hi);
                const bf16x8 xb = *(const LAS bf16x8*)(Xt + (32 * yj + r32) * SS_LD + 16 * ks + 8 * hi);
                Yd = MFMA32(wa, xb, Yd);
                const bf16x8 ca = *(const LAS bf16x8*)(Cm + (32 * yi + r32) * SS_LD + 16 * ks + 8 * hi);
                const bf16x8 sb = *(const LAS bf16x8*)(Sb + (32 * yj + r32) * SS_LD + 16 * ks + 8 * hi);
                Yo = MFMA32(ca, sb, Yo);
            }
            const int p = 32 * yj + r32;
#pragma unroll
            for (int r = 0; r < 16; ++r) {
                const int l = 32 * yi + crow(r, hi);
                float y = Yd[r] + v_ecs[l] * Yo[r];
                y += Dh * bf2f(Xt[p * SS_LD + l]);
                yv[r] = y;
            }
        }
        __syncthreads();
        {
            const int n = 32 * sj + r32;
#pragma unroll
            for (int r = 0; r < 16; ++r) Sb[(32 * si + crow(r, hi)) * SS_LD + n] = f2bf(Sacc[r]);
            const int p = 32 * yj + r32;
#pragma unroll
            for (int r = 0; r < 16; ++r) Bw[(32 * yi + crow(r, hi)) * YS_LD + p] = f2bf(yv[r]);
        }
        tprev = t0;
    }
    __syncthreads();
    {
        const int tid = ltid();
#pragma unroll
        for (int i = 0; i < 2; ++i) { const int c = tid + 512 * i, row = c >> 3, part = c & 7;
            wt16(yout + (size_t)(tprev + row) * ystr + part * 8, *(const LAS u32x4*)(Bw + row * YS_LD + part * 8)); }
    }
    __syncthreads();
}

constexpr int AT_KLD = 104, AT_VLD = 72;
constexpr int AT_K = 0, AT_KB = 64 * AT_KLD * 2, AT_V = 2 * AT_KB, AT_VB = 64 * AT_VLD * 2, AT_WS = AT_V + 2 * AT_VB, AT_ST = AT_WS + NWAVES * 64 * 4;
constexpr int AT_END = AT_ST + NWAVES * 32 * 68 * 4;
static_assert(AT_END <= LDS_BYTES && SS_VEC + 4096 <= LDS_BYTES, "LDS map");
constexpr float QK_SCALE = 0.10206207261596575f * 1.4426950408889634f;

__device__ __forceinline__ void attn_unit(CArgs a, int layer, int unit, LAS unsigned char* lds) {
    const int tid = ltid(), lane = tid & 63, wid = tid >> 6, r32 = lane & 31, hi = lane >> 5;
    const unsigned char* WSB = a->ws;
    const int qb = unit & 7, bh = unit >> 3, h = bh & 7, b = bh >> 3;
    const bf16_t* Kg = (const bf16_t*)(a->ws + WS_KF) + (size_t)bh * SEQ * 96;
    const bf16_t* Vg = (const bf16_t*)(a->ws + WS_VT) + (size_t)bh * SEQ * 64;
    const float2* cst = (const float2*)(a->ws + WS_CS);
    const float* qhn = a->mla_qhn + layer * 96;
    LAS float* wsf = (LAS float*)(lds + AT_WS) + wid * 64;
    const int qrow = b * SEQ + qb * 256 + wid * 32 + r32;
    bf16x8 qf[6]; float mref;
    {
        const bf16_t* qp = (const bf16_t*)(a->ws + WS_QR) + (size_t)qrow * 768 + h * 96;
        float q[6][8]; float ss = 0.f;
#pragma unroll
        for (int s = 0; s < 6; ++s) { unpack8(*(const u32x4*)(qp + 16 * s + 8 * hi), q[s]);
#pragma unroll
            for (int e = 0; e < 8; ++e) ss += q[s][e] * q[s][e]; }
        ss += __shfl_xor(ss, 32);
        const float rq = rsqrtf(ss * (1.f / 96.f) + EPS);
#pragma unroll
        for (int s = 0; s < 6; ++s)
#pragma unroll
            for (int e = 0; e < 8; ++e) q[s][e] *= rq * qhn[16 * s + 8 * hi + e];
#pragma unroll
        for (int e = 0; e < 8; ++e) { const float2 c = cst[(size_t)qrow * 16 + 8 * hi + e]; const float x1 = q[4][e], x2 = q[5][e];
            q[4][e] = x1 * c.x - x2 * c.y; q[5][e] = x1 * c.y + x2 * c.x; }
        float qn2 = 0.f;
#pragma unroll
        for (int s = 0; s < 6; ++s) {
#pragma unroll
            for (int e = 0; e < 8; ++e) { q[s][e] *= QK_SCALE; qn2 += q[s][e] * q[s][e]; }
            qf[s] = __builtin_bit_cast(bf16x8, pack8(q[s]));
        }
        qn2 += __shfl_xor(qn2, 32);
        const float* khn = a->mla_khn + layer * 96;
        float gm = fmaxf(fabsf(khn[lane]), fabsf(khn[64 + (lane & 31)]));
#pragma unroll
        for (int o = 1; o < 64; o <<= 1) gm = fmaxf(gm, __shfl_xor(gm, o));
        mref = 1.02f * sqrtf(qn2) * 9.797958971f * gm;
    }
    u32x4 kr0, kr1, vr;
    const int kc0 = tid, kc1 = tid + 512;
    constexpr int NT = SEQ / 64;
    auto gloadK = [&](int t) {
        const bf16_t* kt = Kg + (size_t)t * 64 * 96;
        kr0 = *(const u32x4*)(kt + kc0 * 8);
        kr1 = *(const u32x4*)(kt + (kc1 < 768 ? kc1 : 767) * 8);
    };
    auto gloadV = [&](int t) { vr = *(const u32x4*)(Vg + (size_t)t * 64 * 64 + tid * 8); };
    auto lstoreK = [&](int buf) {
        LAS bf16_t* Kl = (LAS bf16_t*)(lds + AT_K + buf * AT_KB);
        *(LAS u32x4*)(Kl + (kc0 / 12) * AT_KLD + (kc0 % 12) * 8) = kr0;
        if (kc1 < 768) *(LAS u32x4*)(Kl + (kc1 / 12) * AT_KLD + (kc1 % 12) * 8) = kr1;
    };
    auto lstoreV = [&](int buf) {
        LAS bf16_t* Vl = (LAS bf16_t*)(lds + AT_V + buf * AT_VB);
        *(LAS u32x4*)(Vl + (tid >> 3) * AT_VLD + (tid & 7) * 8) = vr;
    };
    f32x16 negm;
#pragma unroll
    for (int r = 0; r < 16; ++r) negm[r] = -mref;
    auto qk = [&](int buf, f32x16& p0, f32x16& p1) {
        const LAS bf16_t* Kl = (const LAS bf16_t*)(lds + AT_K + buf * AT_KB);
#pragma unroll
        for (int s = 0; s < 6; ++s) {
            const bf16x8 k0 = *(const LAS bf16x8*)(Kl + r32 * AT_KLD + 16 * s + 8 * hi);
            const bf16x8 k1 = *(const LAS bf16x8*)(Kl + (32 + r32) * AT_KLD + 16 * s + 8 * hi);
            if (s == 0) { p0 = MFMA32(k0, qf[0], negm); p1 = MFMA32(k1, qf[0], negm); }
            else { p0 = MFMA32(k0, qf[s], p0); p1 = MFMA32(k1, qf[s], p1); }
        }
    };
    __syncthreads();
    gloadK(0); gloadV(0); lstoreK(0); lstoreV(0); gloadK(1); lstoreK(1);
    __syncthreads();
    float lrun = 0.f;
    f32x16 o0, o1, pA0, pA1, pB0, pB1;
#pragma unroll
    for (int r = 0; r < 16; ++r) { o0[r] = 0.f; o1[r] = 0.f; }
    qk(0, pA0, pA1);
    auto tile = [&](int t, f32x16& c0, f32x16& c1, f32x16& n0, f32x16& n1) {
        const int buf = t & 1;
        gloadK(t + 2 < NT ? t + 2 : NT - 1); gloadV(t + 1 < NT ? t + 1 : NT - 1);
        const LAS bf16_t* Vl = (const LAS bf16_t*)(lds + AT_V + buf * AT_VB);
        if (t + 1 < NT) qk(buf ^ 1, n0, n1);
        f32x16 p0, p1;
        float rs = 0.f;
#pragma unroll
        for (int r = 0; r < 16; ++r) { p0[r] = __builtin_amdgcn_exp2f(c0[r]); p1[r] = __builtin_amdgcn_exp2f(c1[r]); rs += p0[r] + p1[r]; }
        lrun += rs;
        bf16x8 pf[4];
#pragma unroll
        for (int s = 0; s < 2; ++s) {
            u32x4 w0, w1;
            w0.x = cvt_pk_bf16(p0[8 * s], p0[8 * s + 1]); w0.y = cvt_pk_bf16(p0[8 * s + 2], p0[8 * s + 3]); w0.z = cvt_pk_bf16(p0[8 * s + 4], p0[8 * s + 5]); w0.w = cvt_pk_bf16(p0[8 * s + 6], p0[8 * s + 7]);
            w1.x = cvt_pk_bf16(p1[8 * s], p1[8 * s + 1]); w1.y = cvt_pk_bf16(p1[8 * s + 2], p1[8 * s + 3]); w1.z = cvt_pk_bf16(p1[8 * s + 4], p1[8 * s + 5]); w1.w = cvt_pk_bf16(p1[8 * s + 6], p1[8 * s + 7]);
            pf[s] = __builtin_bit_cast(bf16x8, w0); pf[2 + s] = __builtin_bit_cast(bf16x8, w1);
        }
#pragma unroll
        for (int i = 0; i < 12; ++i) { __builtin_amdgcn_sched_group_barrier(0x008, 1, 0); __builtin_amdgcn_sched_group_barrier(0x002, 9, 0); }
#pragma unroll
        for (int s4 = 0; s4 < 4; ++s4) {
            const int kb = 32 * (s4 >> 1) + 16 * (s4 & 1) + 4 * hi;
            const LAS bf16_t* vrow = Vl + (kb - 4 * hi + 4 * hi + ((lane & 15) >> 2)) * AT_VLD + 16 * ((lane >> 4) & 1) + 4 * (lane & 3);
            const v4i16_t a0 = __builtin_amdgcn_ds_read_tr16_b64_v4i16((LAS v4i16_t*)(vrow)), a1 = __builtin_amdgcn_ds_read_tr16_b64_v4i16((LAS v4i16_t*)(vrow + 8 * AT_VLD));
            const v4i16_t c0 = __builtin_amdgcn_ds_read_tr16_b64_v4i16((LAS v4i16_t*)(vrow + 32)), c1 = __builtin_amdgcn_ds_read_tr16_b64_v4i16((LAS v4i16_t*)(vrow + 8 * AT_VLD + 32));
            const bf16x8 v0 = __builtin_shufflevector(a0, a1, 0, 1, 2, 3, 4, 5, 6, 7), v1 = __builtin_shufflevector(c0, c1, 0, 1, 2, 3, 4, 5, 6, 7);
            o0 = MFMA32(pf[s4], v0, o0);
            o1 = MFMA32(pf[s4], v1, o1);
        }
        lstoreK(buf); lstoreV(buf ^ 1);
        __syncthreads();
    };
#pragma unroll 1
    for (int t = 0; t < NT; t += 2) { tile(t, pA0, pA1, pB0, pB1); tile(t + 1, pB0, pB1, pA0, pA1); }
    lrun += __shfl_xor(lrun, 32);
    if (hi == 0) wsf[32 + r32] = 1.f / lrun;
    LAS float* stg = (LAS float*)(lds + AT_ST) + wid * 32 * 68;
#pragma unroll
    for (int r = 0; r < 16; ++r) { const int q = crow(r, hi); const float il = wsf[32 + q]; stg[q * 68 + r32] = o0[r] * il; stg[q * 68 + 32 + r32] = o1[r] * il; }
    {
        const int row = lane >> 1, half = lane & 1;
        float v[32]; float ss = 0.f;
#pragma unroll
        for (int i = 0; i < 8; ++i) { const f32x4 x = *(const LAS f32x4*)(stg + row * 68 + half * 32 + 4 * i); v[4 * i] = x[0]; v[4 * i + 1] = x[1]; v[4 * i + 2] = x[2]; v[4 * i + 3] = x[3];
            ss += (x[0] * x[0] + x[1] * x[1]) + (x[2] * x[2] + x[3] * x[3]); }
        ss += __shfl_xor(ss, 1);
        const float ro = rsqrtf(ss * (1.f / 64.f) + EPS);
        bf16_t* yp = (bf16_t*)(a->ws + WS_Y) + (size_t)(b * SEQ + qb * 256 + wid * 32 + row) * 2048 + 1024 + h * 64 + half * 32;
#pragma unroll
        for (int i = 0; i < 4; ++i) { u32x4 w; w.x = cvt_pk_bf16(v[8 * i] * ro, v[8 * i + 1] * ro); w.y = cvt_pk_bf16(v[8 * i + 2] * ro, v[8 * i + 3] * ro);
            w.z = cvt_pk_bf16(v[8 * i + 4] * ro, v[8 * i + 5] * ro); w.w = cvt_pk_bf16(v[8 * i + 6] * ro, v[8 * i + 7] * ro); wt16(yp + 8 * i, w); }
    }
}

__device__ __forceinline__ void conv_mixer_rows(CArgs a, int layer, int G) {
    const int lane = ltid() & 63, wave = ltid() >> 6;
    const int gw = lbid() * NWAVES + wave, NGW = G * NWAVES;
    const unsigned char* WSB = a->ws;
    const bf16_t* U = (const bf16_t*)(a->ws + WS_U); bf16_t* Y = (bf16_t*)(a->ws + WS_Y);
    const float* cw = a->conv_w + (size_t)layer * 3 * 512;
    const int c0 = lane * 8;
    float w[3][8];
#pragma unroll
    for (int k = 0; k < 3; ++k) { const f32x4 a0 = *(const f32x4*)(cw + k * 512 + c0), a1 = *(const f32x4*)(cw + k * 512 + c0 + 4);
        w[k][0] = a0[0]; w[k][1] = a0[1]; w[k][2] = a0[2]; w[k][3] = a0[3]; w[k][4] = a1[0]; w[k][5] = a1[1]; w[k][6] = a1[2]; w[k][7] = a1[3]; }
    auto load = [&](int row, u32x4 (&raw)[7]) {
        const int s = row & (SEQ - 1);
#pragma unroll
        for (int k = 0; k < 3; ++k) {
            const int sp = s + k - 1; const int rr = (sp >= 0 && sp < SEQ) ? row + k - 1 : row;
            const bf16_t* ur = U + (size_t)rr * NU;
            u32x4 h = *(const u32x4*)(ur + UCH + c0), c = *(const u32x4*)(ur + UCC + c0);
            if (!(sp >= 0 && sp < SEQ)) { h = (u32x4){0u, 0u, 0u, 0u}; c = (u32x4){0u, 0u, 0u, 0u}; }
            raw[2 * k] = h; raw[2 * k + 1] = c;
        }
        raw[6] = *(const u32x4*)(U + (size_t)row * NU + UCB + c0);
    };
    auto finish = [&](int row, const u32x4 (&raw)[7]) {
        float accv[8];
#pragma unroll
        for (int e = 0; e < 8; ++e) accv[e] = 0.f;
#pragma unroll
        for (int k = 0; k < 3; ++k) { float ch[8], cc[8]; unpack8(raw[2 * k], ch); unpack8(raw[2 * k + 1], cc);
#pragma unroll
            for (int e = 0; e < 8; ++e) accv[e] += w[k][e] * (cc[e] * ch[e]); }
        float cbv[8]; unpack8(raw[6], cbv);
        float ss = 0.f;
#pragma unroll
        for (int e = 0; e < 8; ++e) { accv[e] *= cbv[e]; ss += accv[e] * accv[e]; }
        ss += __shfl_xor(ss, 1); ss += __shfl_xor(ss, 2); ss += __shfl_xor(ss, 4);
        const float r = rsqrtf(ss * (1.f / 64.f) + EPS);
#pragma unroll
        for (int e = 0; e < 8; ++e) accv[e] *= r;
        wt16(Y + (size_t)row * 2048 + 1536 + c0, pack8(accv));
    };
    for (int row = gw; row < T; row += 2 * NGW) {
        const int row2 = row + NGW;
        u32x4 ra[7], rb[7];
        load(row, ra);
        if (row2 < T) load(row2, rb);
        finish(row, ra);
        if (row2 < T) finish(row2, rb);
    }
}
__device__ __forceinline__ void ssd_combine_rows(CArgs a, int G) {
    const int lane = ltid() & 63, wave = ltid() >> 6;
    const int gw = lbid() * NWAVES + wave, NGW = G * NWAVES;
    const unsigned char* WSB = a->ws;
    const bf16_t* U = (const bf16_t*)(a->ws + WS_U); bf16_t* Y = (bf16_t*)(a->ws + WS_Y);
    const bf16_t* yb = (const bf16_t*)(a->ws + WS_YF);
    const int c0 = lane * 16;
    auto load = [&](int row, u32x4 (&raw)[6]) {
#pragma unroll
        for (int hf = 0; hf < 2; ++hf) { raw[3 * hf] = *(const u32x4*)(Y + (size_t)row * 2048 + c0 + 8 * hf); raw[3 * hf + 1] = *(const u32x4*)(yb + (size_t)row * 1024 + c0 + 8 * hf);
            raw[3 * hf + 2] = *(const u32x4*)(U + (size_t)row * NU + UZ + c0 + 8 * hf); }
    };
    auto finish = [&](int row, const u32x4 (&raw)[6]) {
        float g[16]; float ss = 0.f;
#pragma unroll
        for (int hf = 0; hf < 2; ++hf) {
            float f[8], bb[8], z[8];
            unpack8(raw[3 * hf], f); unpack8(raw[3 * hf + 1], bb); unpack8(raw[3 * hf + 2], z);
#pragma unroll
            for (int e = 0; e < 8; ++e) { const float y = (f[e] + bb[e]) * silu_f(z[e]); g[8 * hf + e] = y; ss += y * y; }
        }
        ss += __shfl_xor(ss, 1); ss += __shfl_xor(ss, 2); ss += __shfl_xor(ss, 4); ss += __shfl_xor(ss, 8); ss += __shfl_xor(ss, 16);
        const float r = rsqrtf(ss * (1.f / 512.f) + EPS);
        float o0[8], o1[8];
#pragma unroll
        for (int e = 0; e < 8; ++e) { o0[e] = g[e] * r; o1[e] = g[8 + e] * r; }
        wt16(Y + (size_t)row * 2048 + c0, pack8(o0)); wt16(Y + (size_t)row * 2048 + c0 + 8, pack8(o1));
    };
    for (int row = gw; row < T; row += 2 * NGW) {
        const int row2 = row + NGW;
        u32x4 ra[6], rb[6];
        load(row, ra);
        if (row2 < T) load(row2, rb);
        finish(row, ra);
        if (row2 < T) finish(row2, rb);
    }
}

#define XB_TMO      128
#define XB_XCNT(j)  (256  + 64 * (j))
#define XB_XSUB(j)  (1280 + 64 * (j))
#define XB_XGEN(j)  (2304 + 64 * (j))
#define XB_TOP      3328
#define XB_TOPGEN   3392
#define XCD_BAR_WORDS 3456
#define XB_SPIN_CAP (1u << 20)
__device__ __forceinline__ unsigned xb_ld(unsigned* p)              { return __hip_atomic_load(p, __ATOMIC_RELAXED, __HIP_MEMORY_SCOPE_AGENT); }
__device__ __forceinline__ unsigned xb_add(unsigned* p, unsigned v) { return __hip_atomic_fetch_add(p, v, __ATOMIC_RELAXED, __HIP_MEMORY_SCOPE_AGENT); }
__device__ __forceinline__ unsigned xb_xcc_id() { return (unsigned)__builtin_amdgcn_s_getreg((3 << 11) | 20) & 0xFu; }
#define XB_SPIN(cond, bar) do { unsigned _sp = 0; while (cond) { __builtin_amdgcn_s_sleep(1); \
    if ((++_sp & 255u) == 0u) { if (xb_ld(&(bar)[XB_TMO])) break; if (_sp > XB_SPIN_CAP) { atomicAdd(&(bar)[XB_TMO], 1u); break; } } } } while (0)
struct XcdBarrier { unsigned* bar; unsigned x; volatile LAS unsigned* st; };
__device__ __forceinline__ XcdBarrier xcd_barrier_post(unsigned* bar, volatile LAS unsigned* st) {
    XcdBarrier b; b.bar = bar; b.x = xb_xcc_id(); b.st = st;
    if (threadIdx.x == 0) (void)xb_add(&bar[XB_XCNT(b.x)], 1u);
    return b;
}
__device__ __forceinline__ void xcd_barrier_complete(unsigned* bar, unsigned x, unsigned& nloc, unsigned& nx) {
    const unsigned G = gridDim.x * gridDim.y * gridDim.z;
    unsigned sum, cnt, mine, sp = 0u;
    for (;;) {
        sum = 0u; cnt = 0u; mine = 0u;
#pragma unroll
        for (unsigned j = 0; j < 16; ++j) { const unsigned c = xb_ld(&bar[XB_XCNT(j)]); sum += c; cnt += (c > 0u) ? 1u : 0u; mine = (j == x) ? c : mine; }
        if (sum == G) break;
        __builtin_amdgcn_s_sleep(1);
        if ((++sp & 255u) == 0u) { if (xb_ld(&bar[XB_TMO])) break; if (sp > XB_SPIN_CAP) { atomicAdd(&bar[XB_TMO], 1u); break; } }
    }
    nloc = mine > 0u ? mine : 1u; nx = cnt > 0u ? cnt : 1u;
}
__device__ __forceinline__ void xcd_barrier(const XcdBarrier& b) {
    asm volatile("s_waitcnt vmcnt(0)" ::: "memory");
    __syncthreads();
    if (threadIdx.x == 0) {
        unsigned* bar = b.bar;
        __builtin_amdgcn_s_waitcnt(0);
        unsigned nloc = b.st[0], nx = b.st[1];
        if (nloc == 0u) { xcd_barrier_complete(bar, b.x, nloc, nx); b.st[0] = nloc; b.st[1] = nx; }
        const unsigned old = xb_add(&bar[XB_XSUB(b.x)], 1u);
        const unsigned gen = old / nloc;
        if (old + 1u == (gen + 1u) * nloc) {
            const unsigned og = xb_add(&bar[XB_TOP], 1u);
            const unsigned tg = og / nx;
            if (og + 1u == (tg + 1u) * nx) xb_add(&bar[XB_TOPGEN], 1u);
            else XB_SPIN(xb_ld(&bar[XB_TOPGEN]) == tg, bar);
            __builtin_amdgcn_fence(__ATOMIC_ACQUIRE, "agent");
            xb_add(&bar[XB_XGEN(b.x)], 1u);
            asm volatile("s_waitcnt vmcnt(0)" ::: "memory");
        } else {
            XB_SPIN(xb_ld(&bar[XB_XGEN(b.x)]) == gen, bar);
            __builtin_amdgcn_fence(__ATOMIC_ACQUIRE, "agent");
            asm volatile("s_waitcnt vmcnt(0)" ::: "memory");
        }
    }
    __syncthreads();
}
#ifndef PH_MASK
#define PH_MASK 0xff
#endif
#define PH_EN(i) ((PH_MASK >> (i)) & 1)
#ifndef P4_MASK
#define P4_MASK 0xf
#endif
#define P4_EN(i) ((P4_MASK >> (i)) & 1)
constexpr int PH_PER_LAYER = 9, N_PHASES = DEPTH * PH_PER_LAYER;

__global__ void __launch_bounds__(NTHR, 2) mk_fwd(Args a_by_value) {
    extern __shared__ __attribute__((aligned(16))) unsigned char lds_raw[];
    LAS unsigned char* lds = (LAS unsigned char*)lds_raw;
    cg::grid_group grid = cg::this_grid();
    const int G = gridDim.x;
    unsigned char* ws; { CArgs a0 = get_args(); ws = a0->ws; }
    const int ph_lo = get_args()->ph_lo, ph_hi = get_args()->ph_hi;
    float* rowss = (float*)(ws + WS_CTL + CTL_ROWSS);
    bf16_t* U = (bf16_t*)(ws + WS_U); bf16_t* Hb = U; bf16_t* XB = (bf16_t*)(ws + WS_XB); bf16_t* Y = (bf16_t*)(ws + WS_Y);
    unsigned char* wsw = ws + WS_W;
    volatile LAS unsigned* xst = (volatile LAS unsigned*)(lds + LDS_BYTES - 16);
    if (threadIdx.x < 4) xst[threadIdx.x] = 0u;
    __syncthreads();
    XcdBarrier xbar; xbar.bar = (unsigned*)(ws + WS_BAR); xbar.x = 0; xbar.st = xst;
    if (USE_XCD_BAR && ph_hi - ph_lo > 1) xbar = xcd_barrier_post((unsigned*)(ws + WS_BAR), xst);
    for (int ph = ph_lo; ph < ph_hi; ++ph) {
        CArgs a = get_args(); const int bid = lbid();
        const int layer = ph / PH_PER_LAYER, k = ph % PH_PER_LAYER;
        if (PH_EN(0) && k == 0) {
            for (int rep = 0; rep < REP_CV; ++rep) phase_convert(a, layer, lds, G);
        } else if (PH_EN(1) && (k == 1 || k == 7)) {
            pg8::Gemm g{XB, (const bf16_t*)(wsw + (k == 1 ? W_GU1 : W_GU2)), T, 2 * FF, DM, XLD, DM}; pg8::StaticOrder S; S.init(T, 2 * FF, G, bid);
            EpiSwiglu E{ws, Hb, rowss};
            for (int rep = 0; rep < REP_GU; ++rep) pg8::gemm_phase<EpiSwiglu, pg8::StaticOrder, true>(lds, g, S, E);
        } else if (PH_EN(2) && (k == 2 || k == 8)) {
            pg8::Gemm g{Hb, (const bf16_t*)(wsw + (k == 2 ? W_D1 : W_D2)), T, DM, FF, HLD, HLD}; pg8::StaticOrder S; S.init(T, DM, G, bid);
            EpiResid E{ws, (layer == 0 && k == 2) ? a->x : a->out, a->out, XB, rowss, 0.5f};
            pg8::gemm_phase<EpiResid, pg8::StaticOrder, false>(lds, g, S, E);
        } else if (PH_EN(3) && k == 3) {
            pg8::Gemm g{XB, (const bf16_t*)(wsw + W_IN), T, NU, DM, XLD, DM}; pg8::StaticOrder S; S.init(T, NU, G, bid);
            EpiU E{ws, U, rowss, (float*)(ws + WS_CTL + CTL_QSS), (float*)(ws + WS_CTL + CTL_KVSS),
                   (float*)(ws + WS_DT), a->ssd_dt_bias + layer * 32};
            for (int rep = 0; rep < REP_IN; ++rep) pg8::gemm_phase<EpiU, pg8::StaticOrder, true>(lds, g, S, E);
        } else if (PH_EN(4) && k == 4) {
            unsigned* subc = (unsigned*)(ws + WS_BAR) + XCD_BAR_WORDS + 64 * (layer * 8);
            for (int item = bid; item < 256; item += G) { ssd_bc_slice(a, layer, item); sub_arrive(subc + 64 * (item >> 5)); }
            for (int rep4 = 0; rep4 < REP_P4R; ++rep4) {
            if (P4_EN(1)) {
                pg8::Gemm g{U + UQ, (const bf16_t*)(wsw + W_UQ), T, 768, 256, NU, 256}; pg8::StaticOrder S; S.init(T, 768, G, bid);
                EpiQ E{ws, (bf16_t*)(ws + WS_QR), (const float*)(ws + WS_CTL + CTL_QSS)};
                pg8::gemm_phase<EpiQ, pg8::StaticOrder, false>(lds, g, S, E);
            }
            if (P4_EN(2)) {
                pg8::Gemm g{U + UKV, (const bf16_t*)(wsw + W_UKV), T, 1024, 128, NU, 128}; pg8::StaticOrder S; S.init(T, 1024, G, bid);
                EpiKV E{ws, U, (const float*)(ws + WS_CTL + CTL_KVSS), a->mla_khn + layer * 96, (const float2*)(ws + WS_CS), (bf16_t*)(ws + WS_KF), (bf16_t*)(ws + WS_VT)};
                pg8::gemm_phase<EpiKV, pg8::StaticOrder, false>(lds, g, S, E);
            }
            if (P4_EN(3)) conv_mixer_rows(a, layer, G);
            }
            for (int item = bid; item < 256; item += G) { sub_wait(subc + 64 * (item >> 5), 32u); ssd_item(a, layer, item, lds); }
        } else if (PH_EN(5) && k == 5) {
            const int vcu = (G % 8 == 0) ? (bid % 8) * (G / 8) + bid / 8 : bid;
            for (int rep = 0; rep < REP_ATT; ++rep) for (int unit = vcu; unit < 512; unit += G) attn_unit(a, layer, (unit & 255) * 2 + (unit >> 8), lds);
            for (int rep5 = 0; rep5 < REP_CMB; ++rep5) ssd_combine_rows(a, G);
        } else if (PH_EN(6) && k == 6) {
            pg8::Gemm g{Y, (const bf16_t*)(wsw + W_OUT), T, DM, 2048, 2048, 2048}; pg8::StaticOrder S; S.init(T, DM, G, bid);
            EpiResid E{ws, a->out, a->out, XB, rowss, 1.0f};
            pg8::gemm_phase<EpiResid, pg8::StaticOrder, false>(lds, g, S, E);
        }
#if USE_XCD_BAR
        if (ph + 1 < ph_hi) xcd_barrier(xbar);
        if (ph_hi < 0) grid.sync();
#else
        if (ph + 1 < ph_hi) {
            asm volatile("s_waitcnt vmcnt(0)" ::: "memory");
            grid.sync();
            __builtin_amdgcn_fence(__ATOMIC_ACQUIRE, "agent");
        }
#endif
    }
}

extern "C" void kernel_launch(void* const* d_in, const int* in_sizes, int n_in, void* d_out, int out_size, void* d_ws, size_t ws_size, hipStream_t stream) {
    static int grid = 0;
    if (grid == 0) {
        if (n_in != 28 || out_size != T * DM || ws_size < WS_END) { fprintf(stderr, "kernel_launch: bad shapes (n_in %d out %d ws %zu need %zu)\n", n_in, out_size, ws_size, (size_t)WS_END); grid = -1; return; }
        if (hipFuncSetAttribute((const void*)mk_fwd, hipFuncAttributeMaxDynamicSharedMemorySize, LDS_BYTES) != hipSuccess) { fprintf(stderr, "kernel_launch: hipFuncSetAttribute failed\n"); grid = -1; return; }
        int dev = 0, cus = 0, per_cu = 0;
        hipGetDevice(&dev); hipDeviceGetAttribute(&cus, hipDeviceAttributeMultiprocessorCount, dev);
        hipOccupancyMaxActiveBlocksPerMultiprocessor(&per_cu, (const void*)mk_fwd, NTHR, LDS_BYTES);
        if (per_cu < 1) { fprintf(stderr, "kernel_launch: occupancy query says %d blocks/CU\n", per_cu); per_cu = 1; }
        (void)hipGetLastError();
        grid = cus;
    }
    if (grid < 0) return;
    Args a{};
    a.x = (const float*)d_in[0]; a.pos = (const int*)d_in[1];
    a.ffn1_norm = (const float*)d_in[2]; a.ffn1_wg = (const float*)d_in[3]; a.ffn1_wu = (const float*)d_in[4]; a.ffn1_wd = (const float*)d_in[5];
    a.mix_norm = (const float*)d_in[6]; a.w_in = (const float*)d_in[7]; a.ssd_conv_w = (const float*)d_in[8]; a.ssd_conv_b = (const float*)d_in[9];
    a.ssd_dt_bias = (const float*)d_in[10]; a.ssd_a_log = (const float*)d_in[11]; a.ssd_d = (const float*)d_in[12]; a.ssd_norm = (const float*)d_in[13];
    a.mla_q_norm = (const float*)d_in[14]; a.mla_w_uq = (const float*)d_in[15]; a.mla_kv_norm = (const float*)d_in[16]; a.mla_w_ukv = (const float*)d_in[17];
    a.mla_qhn = (const float*)d_in[18]; a.mla_khn = (const float*)d_in[19]; a.mla_out_norm = (const float*)d_in[20]; a.conv_w = (const float*)d_in[21];
    a.conv_out_norm = (const float*)d_in[22]; a.w_out = (const float*)d_in[23]; a.ffn2_norm = (const float*)d_in[24]; a.ffn2_wg = (const float*)d_in[25];
    a.ffn2_wu = (const float*)d_in[26]; a.ffn2_wd = (const float*)d_in[27];
    a.out = (float*)d_out; a.ws = (unsigned char*)d_ws;
#if MK_MULTI
    for (int ph = 0; ph < N_PHASES; ++ph) { a.ph_lo = ph; a.ph_hi = ph + 1; hipLaunchKernelGGL(mk_fwd, dim3(grid), dim3(NTHR), LDS_BYTES, stream, a); }
#else
    a.ph_lo = 0; a.ph_hi = N_PHASES;
    if (hipMemsetAsync((char*)d_ws + WS_BAR, 0, (XCD_BAR_WORDS + 64 * 32) * 4, stream) != hipSuccess) { fprintf(stderr, "kernel_launch: memset of barrier words failed\n"); return; }
    void* args[] = {&a};
    hipError_t e = hipLaunchCooperativeKernel((const void*)mk_fwd, dim3(grid), dim3(NTHR), args, LDS_BYTES, stream);
    if (e != hipSuccess) fprintf(stderr, "cooperative launch failed: %s (grid %d)\n", hipGetErrorString(e), grid);
#endif
}
```
